# Optimizing an MI355X kernel written in HIP

```python
import jax
import jax.numpy as jnp
from jax import lax
import numpy as np

D_MODEL = 1024
BATCH = 4
SEQ = 8192
DEPTH = 1

N_META = 16
EPS = 1e-6

POOL_WINDOWS = (2, 4, 8, 16)
POOL_WIDTH = D_MODEL
POOL_GROUP = POOL_WIDTH // len(POOL_WINDOWS)

SSD_INNER = 2 * D_MODEL
SSD_HEAD_DIM = 64
SSD_HEADS = SSD_INNER // SSD_HEAD_DIM
SSD_GROUPS = 4
SSD_HPG = SSD_HEADS // SSD_GROUPS
SSD_STATE = 128
SSD_CONV = 4
SSD_CHUNK = 128
SSD_CONV_DIM = SSD_INNER + 2 * SSD_GROUPS * SSD_STATE
SSD_LEAD_PAD = SSD_CHUNK - N_META

N_EXPERT_GROUPS = 8
EXPERTS_PER_GROUP = 8
N_EXPERTS = N_EXPERT_GROUPS * EXPERTS_PER_GROUP
TOP_K = 2
D_EXPERT = 512
MOE_BLOCK = 256

IN_WIDTHS = (POOL_WIDTH, SSD_INNER, SSD_CONV_DIM, SSD_HEADS, D_MODEL, D_MODEL)
IN_SPLITS = tuple(int(s) for s in np.cumsum(IN_WIDTHS[:-1]))
D_IN_PROJ = sum(IN_WIDTHS)

kernel_name = 'hybrid_pool_ssd_hier_moe'


def rms_norm(x, g):
    xf = x.astype(jnp.float32)
    y = xf * lax.rsqrt(jnp.mean(xf * xf, axis=-1, keepdims=True) + EPS)
    return (y * g.astype(jnp.float32)).astype(x.dtype)


def pool_mixer(u, w_pool, pool_scale):
    bsz, L, _ = u.shape
    uf = u.astype(jnp.float32)
    s0 = jnp.concatenate([jnp.zeros_like(uf[:, :1]), jnp.cumsum(uf, axis=1)], axis=1)
    t = jnp.arange(L)
    outs = []
    for k, w in enumerate(POOL_WINDOWS):
        lo, hi = k * POOL_GROUP, (k + 1) * POOL_GROUP
        sk = s0[:, :, lo:hi]
        lag = jnp.concatenate([jnp.zeros((bsz, w - 1, POOL_GROUP), jnp.float32), sk[:, :L - w + 1]], axis=1)
        cnt = jnp.minimum(t + 1, w).astype(jnp.float32)[None, :, None]
        d = ((sk[:, 1:] - lag) / cnt - uf[:, :, lo:hi]).astype(u.dtype)
        outs.append(d @ w_pool[k])
    return jnp.concatenate(outs, axis=-1) * pool_scale


def causal_dwconv(x, w, b):
    K = w.shape[0]
    L = x.shape[1]
    xp = jnp.pad(x, ((0, 0), (K - 1, 0), (0, 0)))
    y = xp[:, 0:L] * w[0]
    for k in range(1, K):
        y = y + xp[:, k:k + L] * w[k]
    return y + b


def ssd_chunked(xh, dt, A, bm, cm):
    bsz, lp = xh.shape[:2]
    nc = lp // SSD_CHUNK
    X = (xh * dt[..., None]).reshape(bsz, nc, SSD_CHUNK, SSD_GROUPS, SSD_HPG, SSD_HEAD_DIM)
    adt = (dt * A).reshape(bsz, nc, SSD_CHUNK, SSD_GROUPS, SSD_HPG)
    bc = bm.reshape(bsz, nc, SSD_CHUNK, SSD_GROUPS, SSD_STATE)
    cc = cm.reshape(bsz, nc, SSD_CHUNK, SSD_GROUPS, SSD_STATE)
    a_cs = jnp.cumsum(adt, axis=2)
    causal = jnp.tril(jnp.ones((SSD_CHUNK, SSD_CHUNK), dtype=bool))[None, None, :, :, None, None]
    diff = a_cs[:, :, :, None] - a_cs[:, :, None, :]
    cb = jnp.einsum('bclgn,bcsgn->bclsg', cc, bc)
    scores = cb[..., None] * jnp.exp(jnp.where(causal, diff, -jnp.inf))
    y_diag = jnp.einsum('bclsgr,bcsgrp->bclgrp', scores, X)
    decay_states = jnp.exp(a_cs[:, :, -1:] - a_cs)
    states = jnp.einsum('bclgn,bclgrp->bcgrpn', bc, X * decay_states[..., None])
    chunk_decay = jnp.exp(a_cs[:, :, -1])

    def step(h, inp):
        st, dec = inp
        return h * dec[..., None, None] + st, h

    h0 = jnp.zeros_like(states[:, 0])
    _, prev = lax.scan(step, h0, (jnp.moveaxis(states, 1, 0), jnp.moveaxis(chunk_decay, 1, 0)))
    prev = jnp.moveaxis(prev, 0, 1)
    y_off = jnp.einsum('bclgn,bcgrpn->bclgrp', cc, prev) * jnp.exp(a_cs)[..., None]
    return (y_diag + y_off).reshape(bsz, lp, SSD_HEADS, SSD_HEAD_DIM)


def ssd_mixer(z, xbc, dt_raw, conv_w, conv_b, dt_bias, a_log, d_skip, ssd_norm):
    bsz, L, _ = z.shape
    xbc = jax.nn.silu(causal_dwconv(xbc, conv_w, conv_b)).astype(jnp.float32)
    xs = xbc[..., :SSD_INNER].reshape(bsz, L, SSD_HEADS, SSD_HEAD_DIM)
    bm = xbc[..., SSD_INNER:SSD_INNER + SSD_GROUPS * SSD_STATE].reshape(bsz, L, SSD_GROUPS, SSD_STATE)
    cm = xbc[..., SSD_INNER + SSD_GROUPS * SSD_STATE:].reshape(bsz, L, SSD_GROUPS, SSD_STATE)
    dt = jax.nn.softplus(dt_raw.astype(jnp.float32) + dt_bias.astype(jnp.float32))
    A = -jnp.exp(a_log.astype(jnp.float32))
    padf = lambda a: jnp.pad(a, ((0, 0), (SSD_LEAD_PAD, 0)) + ((0, 0),) * (a.ndim - 2))
    y = ssd_chunked(padf(xs), padf(dt), A, padf(bm), padf(cm))[:, SSD_LEAD_PAD:]
    y = y + d_skip.astype(jnp.float32)[:, None] * xs
    y = y.reshape(bsz, L, SSD_INNER) * jax.nn.silu(z.astype(jnp.float32))
    yg = y.reshape(bsz, L, SSD_GROUPS, SSD_INNER // SSD_GROUPS)
    yg = yg * lax.rsqrt(jnp.mean(yg * yg, axis=-1, keepdims=True) + EPS)
    return (yg.reshape(bsz, L, SSD_INNER) * ssd_norm.astype(jnp.float32)).astype(z.dtype)


def hier_moe(h, w_rg, b_rg, w_re, b_re, w_gu, w_dn):
    bsz, L, D = h.shape
    T = bsz * L
    hf = h.reshape(T, D)
    g_prob = jax.nn.softmax((hf @ w_rg).astype(jnp.float32) + b_rg.astype(jnp.float32), axis=-1)
    g_p, g_idx = lax.top_k(g_prob, 1)
    e_logits = ((hf @ w_re).astype(jnp.float32) + b_re.astype(jnp.float32)).reshape(T, N_EXPERT_GROUPS, EXPERTS_PER_GROUP)
    e_logits = jnp.take_along_axis(e_logits, g_idx[:, :, None], axis=1)[:, 0]
    e_p, e_idx = lax.top_k(jax.nn.softmax(e_logits, axis=-1), TOP_K)
    e_p = e_p / jnp.sum(e_p, axis=-1, keepdims=True)
    weights = g_p * e_p
    experts = g_idx * EXPERTS_PER_GROUP + e_idx
    A = T * TOP_K
    flat_e = experts.reshape(A).astype(jnp.int32)
    flat_w = weights.reshape(A)
    order = jnp.argsort(flat_e)
    se = flat_e[order]
    stok = (order // TOP_K).astype(jnp.int32)
    sw = flat_w[order]
    counts = jnp.bincount(flat_e, length=N_EXPERTS).astype(jnp.int32)
    starts = jnp.cumsum(counts) - counts
    pcounts = (counts + MOE_BLOCK - 1) // MOE_BLOCK * MOE_BLOCK
    pends = jnp.cumsum(pcounts)
    pstarts = pends - pcounts
    dest = pstarts[se] + (jnp.arange(A, dtype=jnp.int32) - starts[se])
    nb = -(-A // MOE_BLOCK) + N_EXPERTS
    P = nb * MOE_BLOCK
    row_tok = jnp.full((P,), T, jnp.int32).at[dest].set(stok)
    row_w = jnp.zeros((P,), jnp.float32).at[dest].set(sw)
    block_e = jnp.minimum(jnp.searchsorted(pends, jnp.arange(nb, dtype=jnp.int32) * MOE_BLOCK, side='right'), N_EXPERTS - 1)
    h_pad = jnp.concatenate([hf, jnp.zeros((1, D), hf.dtype)], axis=0)
    xb = h_pad[row_tok].reshape(nb, MOE_BLOCK, D)

    def expert_block(args):
        xblk, e = args
        gu = xblk @ w_gu[e]
        g, u = jnp.split(gu, 2, axis=-1)
        return (jax.nn.silu(g) * u) @ w_dn[e]

    yb = lax.map(expert_block, (xb, block_e)).reshape(P, D)
    y = yb * row_w[:, None].astype(yb.dtype)
    out = jnp.zeros((T + 1, D), yb.dtype).at[row_tok].add(y)[:T]
    return out.reshape(bsz, L, D)


def setup_inputs(seed: int = 0) -> dict:
    key = jax.random.key(seed)
    ks = jax.random.split(key, 24)
    f = jnp.float32
    nrm = lambda k, shape, s: jax.random.normal(k, shape, f) * s
    dt0 = jnp.exp(jax.random.uniform(ks[8], (DEPTH, SSD_HEADS), f) * (np.log(0.1) - np.log(0.001)) + np.log(0.001))
    return {
        'x': nrm(ks[0], (BATCH, SEQ, D_MODEL), 1.0),
        'meta_tokens': nrm(ks[1], (N_META, D_MODEL), 1.0),
        'norm_mix': 1.0 + nrm(ks[2], (DEPTH, D_MODEL), 0.05),
        'w_in': nrm(ks[3], (DEPTH, D_MODEL, D_IN_PROJ), D_MODEL ** -0.5),
        'pool_w': nrm(ks[4], (DEPTH, len(POOL_WINDOWS), POOL_GROUP, POOL_GROUP), POOL_GROUP ** -0.5),
        'pool_scale': 1.0 + nrm(ks[5], (DEPTH, POOL_WIDTH), 0.05),
        'conv_w': nrm(ks[6], (DEPTH, SSD_CONV, SSD_CONV_DIM), SSD_CONV ** -0.5),
        'conv_b': nrm(ks[7], (DEPTH, SSD_CONV_DIM), 0.02),
        'dt_bias': dt0 + jnp.log(-jnp.expm1(-dt0)),
        'a_log': jnp.log(jax.random.uniform(ks[9], (DEPTH, SSD_HEADS), f, 1.0, 16.0)),
        'd_skip': 1.0 + nrm(ks[10], (DEPTH, SSD_HEADS), 0.1),
        'ssd_norm': 1.0 + nrm(ks[11], (DEPTH, SSD_INNER), 0.05),
        'w_pool_out': nrm(ks[12], (DEPTH, POOL_WIDTH, D_MODEL), POOL_WIDTH ** -0.5),
        'w_ssd_out': nrm(ks[13], (DEPTH, SSD_INNER, D_MODEL), SSD_INNER ** -0.5),
        'w_out': nrm(ks[14], (DEPTH, D_MODEL, D_MODEL), D_MODEL ** -0.5),
        'norm_ffn': 1.0 + nrm(ks[15], (DEPTH, D_MODEL), 0.05),
        'w_router_group': nrm(ks[16], (DEPTH, D_MODEL, N_EXPERT_GROUPS), D_MODEL ** -0.5),
        'b_router_group': nrm(ks[17], (DEPTH, N_EXPERT_GROUPS), 0.01),
        'w_router_expert': nrm(ks[18], (DEPTH, D_MODEL, N_EXPERTS), D_MODEL ** -0.5),
        'b_router_expert': nrm(ks[19], (DEPTH, N_EXPERTS), 0.01),
        'w_gate_up': nrm(ks[20], (DEPTH, N_EXPERTS, D_MODEL, 2 * D_EXPERT), D_MODEL ** -0.5),
        'w_down': nrm(ks[21], (DEPTH, N_EXPERTS, D_EXPERT, D_MODEL), D_EXPERT ** -0.5),
        'norm_final': 1.0 + nrm(ks[22], (D_MODEL,), 0.05),
    }


def reference(x, meta_tokens, norm_mix, w_in, pool_w, pool_scale, conv_w, conv_b, dt_bias, a_log, d_skip,
              ssd_norm, w_pool_out, w_ssd_out, w_out, norm_ffn, w_router_group, b_router_group,
              w_router_expert, b_router_expert, w_gate_up, w_down, norm_final):
    bsz = x.shape[0]
    meta = jnp.broadcast_to(meta_tokens.astype(x.dtype)[None], (bsz, N_META, D_MODEL))
    h = jnp.concatenate([meta, x], axis=1)
    for i in range(DEPTH):
        hn = rms_norm(h, norm_mix[i])
        proj = hn @ w_in[i]
        u, z, xbc, dt_raw, g_pool, g_ssd = jnp.split(proj, IN_SPLITS, axis=-1)
        y_pool = pool_mixer(u, pool_w[i], pool_scale[i]) @ w_pool_out[i]
        y_ssd = ssd_mixer(z, xbc, dt_raw, conv_w[i], conv_b[i], dt_bias[i], a_log[i], d_skip[i], ssd_norm[i]) @ w_ssd_out[i]
        merged = jax.nn.sigmoid(g_pool) * y_pool + jax.nn.sigmoid(g_ssd) * y_ssd
        h = h + merged @ w_out[i]
        h = h + hier_moe(rms_norm(h, norm_ffn[i]), w_router_group[i], b_router_group[i],
                         w_router_expert[i], b_router_expert[i], w_gate_up[i], w_down[i])
    return rms_norm(h, norm_final)[:, N_META:]
```

```cpp
#include <hip/hip_runtime.h>
#include <cstdio>
#include <cstdint>
namespace pg8 {
#define PG8_LAS __attribute__((address_space(3)))
typedef unsigned short bf16_t;
typedef short bf16x8 __attribute__((ext_vector_type(8)));
typedef float f32x4 __attribute__((ext_vector_type(4)));
typedef unsigned u32x4 __attribute__((ext_vector_type(4)));
constexpr int BM = 256, BK = 64, HALF = 128, HTB = HALF * BK * 2  , STAGE_BYTES = 8 * HTB, NXCD = 8, WGM = 8;

__host__ __device__ __forceinline__ int lds_byte(int r, int c) { const int st = (r >> 4) * 2 + (c >> 5), rr = r & 15, cc = c & 31, ob = rr * 64 + cc * 2; return st * 1024 + (ob ^ (((ob >> 9) & 1) << 5)); }
__host__ __device__ __forceinline__ void stage_rc(int b, int& R, int& C) { const int st = b / 1024, sb = b % 1024, swz = sb ^ (((sb >> 9) & 1) << 5); R = (st >> 1) * 16 + swz / 64; C = (st & 1) * 32 + (swz % 64) / 2; }
__host__ __device__ __forceinline__ int perm32(int rho) { const int n = rho >> 4, i = rho & 15; return 8 * (i >> 2) + 4 * n + (i & 3); }

struct Unit { int pm, pn; };
struct Gemm { const bf16_t* A; const bf16_t* Bt; int M, N, K; };

struct StaticOrder {
    int nM, nN, nwg, G, c;
    __host__ __device__ void init(int M, int N, int G_, int c_) { nM = M / BM; nN = N / BM; nwg = nM * nN; G = G_; c = c_; }
    __host__ __device__ bool next(int i, Unit& u) const {
        const long L = (long)i * G + c; if (L >= nwg) return false;
        int wgid = (int)L; { const int q = nwg / NXCD, r = nwg % NXCD, xcd = wgid % NXCD, off = wgid / NXCD; wgid = (xcd < r ? xcd * (q + 1) : r * (q + 1) + (xcd - r) * q) + off; }
        const int nig = WGM * nN, gid = wgid / nig, fm = gid * WGM, gsz = (nM - fm) < WGM ? (nM - fm) : WGM;
        u.pm = fm + ((wgid % nig) % gsz); u.pn = (wgid % nig) / gsz; return true;
    }
    __device__ __forceinline__ void a_ready(const Unit&) const {}
    __device__ __forceinline__ void done(const Unit&) const {}
};

typedef __bf16 bf16x2n __attribute__((ext_vector_type(2)));
__device__ __forceinline__ unsigned cvt_pk_bf16(float lo, float hi) { typedef float f32x2c __attribute__((ext_vector_type(2))); const f32x2c v = {lo, hi}; return __builtin_bit_cast(unsigned, __builtin_convertvector(v, bf16x2n)); }
typedef float f32x2 __attribute__((ext_vector_type(2)));

#define PG8_GAS __attribute__((address_space(1)))
__device__ __forceinline__ float sigmoid_f(float x) { return __builtin_amdgcn_rcpf(1.0f + __expf(-x)); }
__device__ __forceinline__ float silu_f(float x) { return x * sigmoid_f(x); }
__device__ __forceinline__ float softplus_f(float x) { return fmaxf(x, 0.f) + log1pf(__expf(-fabsf(x))); }
__device__ __forceinline__ float bf_lo(unsigned w) { return __uint_as_float(w << 16); }
__device__ __forceinline__ float bf_hi(unsigned w) { return __uint_as_float(w & 0xffff0000u); }

struct EpiProj {
    static constexpr bool PERM = true, AFTER_DRAIN = false;
    bf16_t *U, *Z, *XBC, *GATE; float* DT; const float* dt_bias;
    __device__ __forceinline__ void operator()(const f32x4 (&acc)[2][2][4][2], const Unit& u, int wr, int wc, int fr, int fq) const {
        const int row0 = u.pm * BM + wr * 64 + fr;
        if (u.pn < 32) {
            bf16_t* base; int ldc, ct; const bool sig = (u.pn >= 24);
            if (u.pn < 4) { base = U; ldc = 1024; ct = u.pn; }
            else if (u.pn < 12) { base = Z; ldc = 2048; ct = u.pn - 4; }
            else if (u.pn < 24) { base = XBC; ldc = 3072; ct = u.pn - 12; }
            else { base = GATE; ldc = 2048; ct = u.pn - 24; }
            const int col0 = ct * BM + wc * 32 + 8 * fq;
#pragma unroll
            for (int ai = 0; ai < 2; ++ai)
#pragma unroll
                for (int m = 0; m < 4; ++m) { bf16_t* rowp = base + (size_t)(row0 + ai * HALF + m * 16) * ldc + col0;
#pragma unroll
                    for (int bj = 0; bj < 2; ++bj) { f32x4 v0 = acc[ai][bj][m][0], v1 = acc[ai][bj][m][1];
                        if (sig) {
#pragma unroll
                            for (int j = 0; j < 4; ++j) { v0[j] = sigmoid_f(v0[j]); v1[j] = sigmoid_f(v1[j]); } }
                        u32x4 w; w.x = cvt_pk_bf16(v0[0], v0[1]); w.y = cvt_pk_bf16(v0[2], v0[3]); w.z = cvt_pk_bf16(v1[0], v1[1]); w.w = cvt_pk_bf16(v1[2], v1[3]);
                        *(PG8_GAS u32x4*)(rowp + bj * HALF) = w; } }
        } else if (wc == 0) {
            const f32x4 b0 = *(const f32x4*)(dt_bias + 8 * fq), b1 = *(const f32x4*)(dt_bias + 8 * fq + 4);
#pragma unroll
            for (int ai = 0; ai < 2; ++ai)
#pragma unroll
                for (int m = 0; m < 4; ++m) { float* rowp = DT + (size_t)(row0 + ai * HALF + m * 16) * 32 + 8 * fq;
                    f32x4 v0 = acc[ai][0][m][0] + b0, v1 = acc[ai][0][m][1] + b1;
#pragma unroll
                    for (int j = 0; j < 4; ++j) { v0[j] = softplus_f(v0[j]); v1[j] = softplus_f(v1[j]); }
                    *(PG8_GAS f32x4*)rowp = v0; *(PG8_GAS f32x4*)(rowp + 4) = v1; }
        }
    }
};
struct EpiGateMul {
    static constexpr bool PERM = true, AFTER_DRAIN = false;
    const bf16_t* gate; int ldg; const bf16_t* add; bf16_t* O;
    __device__ __forceinline__ void operator()(const f32x4 (&acc)[2][2][4][2], const Unit& u, int wr, int wc, int fr, int fq) const {
        const int row0 = u.pm * BM + wr * 64 + fr, col0 = u.pn * BM + wc * 32 + 8 * fq;
#pragma unroll
        for (int ai = 0; ai < 2; ++ai)
#pragma unroll
            for (int m = 0; m < 4; ++m) { const size_t r = (size_t)(row0 + ai * HALF + m * 16);
#pragma unroll
                for (int bj = 0; bj < 2; ++bj) { const int c = col0 + bj * HALF;
                    const u32x4 gw = *(const PG8_GAS u32x4*)(gate + r * ldg + c);
                    f32x4 v0 = acc[ai][bj][m][0], v1 = acc[ai][bj][m][1];
                    v0[0] *= bf_lo(gw.x); v0[1] *= bf_hi(gw.x); v0[2] *= bf_lo(gw.y); v0[3] *= bf_hi(gw.y);
                    v1[0] *= bf_lo(gw.z); v1[1] *= bf_hi(gw.z); v1[2] *= bf_lo(gw.w); v1[3] *= bf_hi(gw.w);
                    if (add) { const u32x4 aw = *(const PG8_GAS u32x4*)(add + r * 1024 + c);
                        v0[0] += bf_lo(aw.x); v0[1] += bf_hi(aw.x); v0[2] += bf_lo(aw.y); v0[3] += bf_hi(aw.y);
                        v1[0] += bf_lo(aw.z); v1[1] += bf_hi(aw.z); v1[2] += bf_lo(aw.w); v1[3] += bf_hi(aw.w); }
                    u32x4 w; w.x = cvt_pk_bf16(v0[0], v0[1]); w.y = cvt_pk_bf16(v0[2], v0[3]); w.z = cvt_pk_bf16(v1[0], v1[1]); w.w = cvt_pk_bf16(v1[2], v1[3]);
                    *(PG8_GAS u32x4*)(O + r * 1024 + c) = w; } }
    }
};
struct EpiResid {
    static constexpr bool PERM = false, AFTER_DRAIN = false;
    const float* res; float* C;
    __device__ __forceinline__ void operator()(const f32x4 (&acc)[2][2][4][2], const Unit& u, int wr, int wc, int fr, int fq) const {
        const int row0 = u.pm * BM + wr * 64 + fr, col0 = u.pn * BM + wc * 32 + 4 * fq;
#pragma unroll
        for (int ai = 0; ai < 2; ++ai)
#pragma unroll
            for (int m = 0; m < 4; ++m) { const size_t off = (size_t)(row0 + ai * HALF + m * 16) * 1024 + col0;
#pragma unroll
                for (int bj = 0; bj < 2; ++bj)
#pragma unroll
                    for (int n = 0; n < 2; ++n) { const f32x4 rv = *(const PG8_GAS f32x4*)(res + off + bj * HALF + n * 16);
                        *(PG8_GAS f32x4*)(C + off + bj * HALF + n * 16) = acc[ai][bj][m][n] + rv; } }
    }
};
struct EpiSwiGLU {
    static constexpr bool PERM = true, AFTER_DRAIN = false;
    bf16_t* ACT;
    __device__ __forceinline__ void operator()(const f32x4 (&acc)[2][2][4][2], const Unit& u, int wr, int wc, int fr, int fq) const {
        const int row0 = u.pm * BM + wr * 64 + fr, col0 = (u.pn & 3) * HALF + wc * 32 + 8 * fq;
#pragma unroll
        for (int ai = 0; ai < 2; ++ai)
#pragma unroll
            for (int m = 0; m < 4; ++m) { f32x4 v0, v1;
#pragma unroll
                for (int j = 0; j < 4; ++j) { v0[j] = silu_f(acc[ai][0][m][0][j]) * acc[ai][1][m][0][j]; v1[j] = silu_f(acc[ai][0][m][1][j]) * acc[ai][1][m][1][j]; }
                u32x4 w; w.x = cvt_pk_bf16(v0[0], v0[1]); w.y = cvt_pk_bf16(v0[2], v0[3]); w.z = cvt_pk_bf16(v1[0], v1[1]); w.w = cvt_pk_bf16(v1[2], v1[3]);
                *(PG8_GAS u32x4*)(ACT + (size_t)(row0 + ai * HALF + m * 16) * 512 + col0) = w; }
    }
};
struct EpiMoeDown {
    static constexpr bool PERM = true, AFTER_DRAIN = false;
    const int* row_a; const float* row_w; bf16_t* SLOT; const PG8_LAS unsigned* tbl;
    __device__ __forceinline__ void operator()(const f32x4 (&acc)[2][2][4][2], const Unit& u, int wr, int wc, int fr, int fq) const {
        const int nvalid = (int)(tbl[u.pm] >> 8);
        const int lr0 = wr * 64 + fr, col0 = (u.pn & 3) * BM + wc * 32 + 8 * fq;
#pragma unroll
        for (int ai = 0; ai < 2; ++ai)
#pragma unroll
            for (int m = 0; m < 4; ++m) { const int lr = lr0 + ai * HALF + m * 16;
                if (lr < nvalid) { const int gr = u.pm * BM + lr; const int a = row_a[gr]; const float w = row_w[gr];
#pragma unroll
                    for (int bj = 0; bj < 2; ++bj) { const f32x4 v0 = acc[ai][bj][m][0] * w, v1 = acc[ai][bj][m][1] * w;
                        u32x4 o; o.x = cvt_pk_bf16(v0[0], v0[1]); o.y = cvt_pk_bf16(v0[2], v0[3]); o.z = cvt_pk_bf16(v1[0], v1[1]); o.w = cvt_pk_bf16(v1[2], v1[3]);
                        *(PG8_GAS u32x4*)(SLOT + (size_t)a * 1024 + col0 + bj * HALF) = o; } } }
    }
};
struct EpiRouter {
    static constexpr bool PERM = false, AFTER_DRAIN = true;
    const float *b_rg, *b_re; int* asg_e; int* asg_pos; float* asg_w; unsigned* cnt;
    __device__ __forceinline__ void fused(f32x4 (&acc)[2][2][4][2], const Unit& u, int wr, int wc, int fr, int fq, PG8_LAS unsigned char* lds, int wid, int lane) const {
        PG8_LAS float* L = (PG8_LAS float*)lds;
        if (wc < 3) {
#pragma unroll
            for (int ai = 0; ai < 2; ++ai)
#pragma unroll
                for (int m = 0; m < 4; ++m) { const int r = ai * HALF + wr * 64 + m * 16 + fr;
#pragma unroll
                    for (int n = 0; n < 2; ++n) { const int c = wc * 32 + n * 16 + 4 * fq;
                        if (c < 72) {
#pragma unroll
                            for (int j = 0; j < 4; ++j) L[r * 73 + c + j] = acc[ai][0][m][n][j]; } } }
        }
        asm volatile("s_waitcnt lgkmcnt(0)" ::: "memory"); __builtin_amdgcn_s_barrier(); asm volatile("" ::: "memory");
        const int tid = wid * 64 + lane;
        if (tid < 256) {
            const PG8_LAS float* lr = L + tid * 73;
            float gl[8]; float gm = -3.0e38f; int gi = 0;
#pragma unroll
            for (int j = 0; j < 8; ++j) { gl[j] = lr[j] + b_rg[j]; if (gl[j] > gm) { gm = gl[j]; gi = j; } }
            float gs = 0.f;
#pragma unroll
            for (int j = 0; j < 8; ++j) gs += __expf(gl[j] - gm);
            const float g_p = 1.0f / gs;
            float e1 = -3.0e38f, e2 = -3.0e38f; int i1 = 0, i2 = 0;
#pragma unroll
            for (int j = 0; j < 8; ++j) { const float v = lr[8 + gi * 8 + j] + b_re[gi * 8 + j];
                if (v > e1) { e2 = e1; i2 = i1; e1 = v; i1 = j; } else if (v > e2) { e2 = v; i2 = j; } }
            const float t = __expf(e2 - e1), w1 = 1.0f / (1.0f + t), w2 = t * w1;
            const int tok = u.pm * BM + tid, x1 = gi * 8 + i1, x2 = gi * 8 + i2;
            const int p1 = (int)__hip_atomic_fetch_add(cnt + x1, 1u, __ATOMIC_RELAXED, __HIP_MEMORY_SCOPE_AGENT);
            const int p2 = (int)__hip_atomic_fetch_add(cnt + x2, 1u, __ATOMIC_RELAXED, __HIP_MEMORY_SCOPE_AGENT);
            asg_e[2 * tok] = x1; asg_pos[2 * tok] = p1; asg_w[2 * tok] = g_p * w1;
            asg_e[2 * tok + 1] = x2; asg_pos[2 * tok + 1] = p2; asg_w[2 * tok + 1] = g_p * w2;
        }
    }
};
struct MoeOrder {
    const PG8_LAS unsigned* tbl; int nunits, G, c;
    __device__ __forceinline__ bool next(int i, Unit& u) const {
        const int L = i * G + c; if (L >= nunits) return false;
        const int blk = L >> 2; const int e = (int)(__builtin_amdgcn_readfirstlane(tbl[blk]) & 0xffu);
        u.pm = blk; u.pn = e * 4 + (L & 3); return true;
    }
    __device__ __forceinline__ void a_ready(const Unit&) const {}
    __device__ __forceinline__ void done(const Unit&) const {}
};
template <class Epi, class Sched, bool ALIGN_EPI = false, bool SP2 = false>
__device__ __forceinline__ void gemm_phase(PG8_LAS unsigned char* lds, const Gemm g, const Sched& S, const Epi& E) {
    const int tid = threadIdx.x, wid = __builtin_amdgcn_readfirstlane(tid >> 6), lane = tid & 63, wr = wid >> 2, wc = wid & 3, fr = lane & 15, fq = lane >> 4;
    const int K = g.K, nt = K / BK;
    unsigned voffA[2], voffB[2];
#pragma unroll
    for (int i = 0; i < 2; ++i) { int R, C; stage_rc(tid * 16 + i * 8192, R, C); const int Rb = Epi::PERM ? ((R & ~31) + perm32(R & 31)) : R;
        voffA[i] = (unsigned)(R * K + C) * 2u; voffB[i] = (unsigned)(Rb * K + C) * 2u; }
    const size_t kstep = (size_t)(BK * 2);
    const size_t hstep = (size_t)HALF * K * 2;
    const size_t tstep = 2 * hstep;
    const unsigned ldsw = (unsigned)wid * 1024u;
    const int aoff = lds_byte(wr * 64 + fr, fq * 8), boff = lds_byte(wc * 32 + fr, fq * 8);
#define PG8_SA(b, h) (((b) * 2 + (h)) * HTB)
#define PG8_SB(b, h) ((4 + (b) * 2 + (h)) * HTB)
#define PG8_STAGE(bufoff, gbase, voff) do { _Pragma("unroll") for (int _i = 0; _i < 2; ++_i) \
        __builtin_amdgcn_global_load_lds((const unsigned*)((const char*)(gbase) + (voff)[_i]), (PG8_LAS unsigned*)(lds + (bufoff) + ldsw + _i * 8192), 16, 0, 0); } while (0)
#define PG8_LDA(dst, b, h) do { _Pragma("unroll") for (int m = 0; m < 4; ++m) _Pragma("unroll") for (int k = 0; k < 2; ++k) dst[m][k] = *(const PG8_LAS bf16x8*)(lds + PG8_SA(b, h) + aoff + m * 2048 + k * 1024); } while (0)
#define PG8_LDB(dst, b, h) do { _Pragma("unroll") for (int n = 0; n < 2; ++n) _Pragma("unroll") for (int k = 0; k < 2; ++k) dst[n][k] = *(const PG8_LAS bf16x8*)(lds + PG8_SB(b, h) + boff + n * 2048 + k * 1024); } while (0)
#define PG8_MMA(ai, bj, At, Bt) do { __builtin_amdgcn_s_setprio(1); _Pragma("unroll") for (int m = 0; m < 4; ++m) _Pragma("unroll") for (int n = 0; n < 2; ++n) _Pragma("unroll") for (int k = 0; k < 2; ++k) \
        acc[ai][bj][m][n] = __builtin_amdgcn_mfma_f32_16x16x32_bf16(Bt[n][k], At[m][k], acc[ai][bj][m][n], 0, 0, 0); __builtin_amdgcn_s_setprio(0); } while (0)
#define PG8_WAIT_V(n) asm volatile("s_waitcnt vmcnt(" #n ")" ::: "memory")
#define PG8_WAIT_L(n) asm volatile("s_waitcnt lgkmcnt(" #n ")" ::: "memory")
#define PG8_BAR __builtin_amdgcn_s_barrier()
#define PG8_SCHED __builtin_amdgcn_sched_barrier(0)
    Unit cur, nxt; int ui = 0;
    if (!S.next(0, cur)) return;
    f32x4 acc[2][2][4][2];
#pragma unroll
    for (int a = 0; a < 2; ++a)
#pragma unroll
        for (int b = 0; b < 2; ++b)
#pragma unroll
            for (int m = 0; m < 4; ++m)
#pragma unroll
                for (int n = 0; n < 2; ++n) acc[a][b][m][n] = (f32x4){0.f, 0.f, 0.f, 0.f};
    bf16x8 At[4][2], B0[2][2], B1[2][2];
    const char* cA = (const char*)g.A + (size_t)cur.pm * tstep; const char* cB = (const char*)g.Bt + (size_t)cur.pn * tstep;
    S.a_ready(cur);
    if constexpr (SP2) {
        PG8_STAGE(PG8_SB(0, 0), cB, voffB); PG8_STAGE(PG8_SB(0, 1), cB + hstep, voffB); PG8_STAGE(PG8_SA(0, 0), cA, voffA); PG8_STAGE(PG8_SA(0, 1), cA + hstep, voffA);
        if (wr == 1) PG8_BAR;
        PG8_WAIT_V(2); PG8_BAR;
        PG8_STAGE(PG8_SB(1, 0), cB + kstep, voffB); PG8_STAGE(PG8_SA(1, 0), cA + kstep, voffA); PG8_STAGE(PG8_SB(1, 1), cB + hstep + kstep, voffB);
        PG8_WAIT_V(6); PG8_BAR;
    } else {
        PG8_STAGE(PG8_SB(0, 0), cB, voffB); PG8_STAGE(PG8_SA(0, 0), cA, voffA); PG8_STAGE(PG8_SB(0, 1), cB + hstep, voffB); PG8_STAGE(PG8_SA(0, 1), cA + hstep, voffA);
        if (wr == 1) PG8_BAR;
        PG8_WAIT_V(4); PG8_BAR;
        PG8_STAGE(PG8_SB(1, 0), cB + kstep, voffB); PG8_STAGE(PG8_SA(1, 0), cA + kstep, voffA); PG8_STAGE(PG8_SB(1, 1), cB + hstep + kstep, voffB);
        PG8_WAIT_V(6); PG8_BAR;
    }
    for (;;) {
        const bool has_next = S.next(ui + 1, nxt);
        const char* nA = has_next ? (const char*)g.A + (size_t)nxt.pm * tstep : cA; const char* nB = has_next ? (const char*)g.Bt + (size_t)nxt.pn * tstep : cB;
        for (int t = 0; t < nt; t += 2) {
            const bool last = (t == nt - 2);
            const char* a1 = cA + (size_t)(t + 1) * kstep;
            const char* a2 = last ? nA : cA + (size_t)(t + 2) * kstep; const char* b2 = last ? nB : cB + (size_t)(t + 2) * kstep;
            const char* a3 = a2 + kstep; const char* b3 = b2 + kstep;
            if (last && has_next) S.a_ready(nxt);
            if constexpr (SP2) {
            PG8_LDB(B0, 0, 0); PG8_LDB(B1, 0, 1); PG8_SCHED; PG8_LDA(At, 0, 0); PG8_STAGE(PG8_SA(1, 1), a1 + hstep, voffA);
            PG8_WAIT_V(8); PG8_WAIT_L(0); PG8_BAR; PG8_MMA(0, 0, At, B0); PG8_MMA(0, 1, At, B1); PG8_BAR; PG8_SCHED;
            PG8_LDA(At, 0, 1); PG8_STAGE(PG8_SB(0, 0), b2, voffB); PG8_STAGE(PG8_SB(0, 1), b2 + hstep, voffB); PG8_STAGE(PG8_SA(0, 0), a2, voffA);
            PG8_WAIT_V(8); PG8_WAIT_L(0); PG8_BAR; PG8_MMA(1, 0, At, B0); PG8_MMA(1, 1, At, B1); PG8_BAR; PG8_SCHED;
            PG8_LDB(B0, 1, 0); PG8_LDB(B1, 1, 1); PG8_SCHED; PG8_LDA(At, 1, 0); PG8_STAGE(PG8_SA(0, 1), a2 + hstep, voffA);
            PG8_WAIT_V(8); PG8_WAIT_L(0); PG8_BAR; PG8_MMA(0, 0, At, B0); PG8_MMA(0, 1, At, B1); PG8_BAR; PG8_SCHED;
            PG8_LDA(At, 1, 1); PG8_STAGE(PG8_SB(1, 0), b3, voffB); PG8_STAGE(PG8_SB(1, 1), b3 + hstep, voffB); PG8_STAGE(PG8_SA(1, 0), a3, voffA);
            PG8_WAIT_V(8); PG8_WAIT_L(0); PG8_BAR; PG8_MMA(1, 0, At, B0); PG8_MMA(1, 1, At, B1); PG8_BAR; PG8_SCHED;
            } else {
            PG8_LDB(B0, 0, 0); PG8_SCHED; PG8_LDA(At, 0, 0); PG8_STAGE(PG8_SA(1, 1), a1 + hstep, voffA);
            PG8_WAIT_L(8); PG8_BAR; PG8_WAIT_L(0); PG8_MMA(0, 0, At, B0); PG8_BAR; PG8_SCHED;
            PG8_LDB(B1, 0, 1); PG8_STAGE(PG8_SB(0, 0), b2, voffB);
            PG8_BAR; PG8_WAIT_L(0); PG8_MMA(0, 1, At, B1); PG8_BAR;
            PG8_LDA(At, 0, 1); PG8_STAGE(PG8_SA(0, 0), a2, voffA);
            PG8_BAR; PG8_WAIT_L(0); PG8_MMA(1, 0, At, B0); PG8_BAR; PG8_SCHED;
            PG8_STAGE(PG8_SB(0, 1), b2 + hstep, voffB);
            PG8_WAIT_V(6); PG8_BAR; PG8_MMA(1, 1, At, B1); PG8_BAR;
            PG8_LDB(B0, 1, 0); PG8_SCHED; PG8_LDA(At, 1, 0); PG8_STAGE(PG8_SA(0, 1), a2 + hstep, voffA);
            PG8_WAIT_L(8); PG8_BAR; PG8_WAIT_L(0); PG8_MMA(0, 0, At, B0); PG8_BAR; PG8_SCHED;
            PG8_LDB(B1, 1, 1); PG8_STAGE(PG8_SB(1, 0), b3, voffB);
            PG8_BAR; PG8_WAIT_L(0); PG8_MMA(0, 1, At, B1); PG8_BAR;
            PG8_LDA(At, 1, 1); PG8_STAGE(PG8_SA(1, 0), a3, voffA);
            PG8_BAR; PG8_WAIT_L(0); PG8_MMA(1, 0, At, B0); PG8_BAR; PG8_SCHED;
            PG8_STAGE(PG8_SB(1, 1), b3 + hstep, voffB);
            PG8_WAIT_V(6); PG8_BAR; PG8_MMA(1, 1, At, B1); PG8_BAR;
            }
        }
        if constexpr (ALIGN_EPI) { if (wr == 0) PG8_BAR; }
        if constexpr (!Epi::AFTER_DRAIN) { E(acc, cur, wr, wc, fr, fq); S.done(cur); }
        if (!has_next) break;
#pragma unroll
        for (int a = 0; a < 2; ++a)
#pragma unroll
            for (int b = 0; b < 2; ++b)
#pragma unroll
                for (int m = 0; m < 4; ++m)
#pragma unroll
                    for (int n = 0; n < 2; ++n) acc[a][b][m][n] = (f32x4){0.f, 0.f, 0.f, 0.f};
        cur = nxt; cA = nA; cB = nB; ++ui;
        if constexpr (ALIGN_EPI) { if (wr == 1) PG8_BAR; }
    }
    PG8_WAIT_V(0);
    if constexpr (!ALIGN_EPI) { if (wr == 0) PG8_BAR; }
    PG8_BAR;
    if constexpr (Epi::AFTER_DRAIN) { E.fused(acc, cur, wr, wc, fr, fq, lds, wid, lane); S.done(cur); }
#undef PG8_SA
#undef PG8_SB
#undef PG8_STAGE
#undef PG8_LDA
#undef PG8_LDB
#undef PG8_MMA
#undef PG8_WAIT_V
#undef PG8_WAIT_L
#undef PG8_BAR
#undef PG8_SCHED
}
}

constexpr int NWAVES = 8, NTHR = 512;
#ifndef MK_ONE_LAUNCH
#define MK_ONE_LAUNCH 1
#endif
constexpr int NPHASE = 13;

constexpr int BATCH = 4, SEQ = 8192, DM = 1024, NMETA = 16;
constexpr int TOK = BATCH * SEQ;
constexpr int METAROW = TOK;
constexpr int MROWS = TOK + 256;
constexpr int DIN = 8224, NPROJ = 8448;
constexpr int SSD_INNER = 2048, HEADS = 32, HD = 64, GROUPS = 4, HPG = 8, NSTATE = 128, CHUNK = 128, CONVD = 3072;
constexpr int NCH = 65, PADLEN = NCH * CHUNK;
constexpr int NEXP = 64, DEXP = 512, MAXBLK = 320;
constexpr float EPS = 1e-6f;

constexpr size_t MiB = 1ull << 20;
constexpr size_t WS_CTL = 0, CTL_ZERO_BYTES = 1 * MiB;
constexpr size_t WS_ASGE = 1 * MiB, WS_ASGP = WS_ASGE + 262144, WS_ASGW = WS_ASGP + 262144, WS_ROWA = WS_ASGW + 262144, WS_ROWW = WS_ROWA + 327680;
constexpr size_t WS_WIN = 8 * MiB, WS_WPE = 25 * MiB, WS_WSO = 27 * MiB, WS_WOUT = 31 * MiB, WS_WR = 33 * MiB;
constexpr size_t WS_DT = 34 * MiB, WS_ACS = 39 * MiB, WS_DTC = 44 * MiB;
constexpr size_t WS_XN = 50 * MiB, WS_U = 115 * MiB, WS_Z = 180 * MiB, WS_XBC = 309 * MiB, WS_GATE = 503 * MiB, WS_D = 632 * MiB;
constexpr size_t WS_XST = 696 * MiB, WS_BT = 826 * MiB, WS_CN = 859 * MiB, WS_G = 892 * MiB;
constexpr size_t WS_Y = 50 * MiB, WS_YN = 309 * MiB, WS_TMP = 437 * MiB, WS_WGU = 696 * MiB, WS_WDN = 824 * MiB, WS_MERGED = 926 * MiB;
constexpr size_t WS_H2 = 180 * MiB, WS_H2N = 50 * MiB, WS_XS = 309 * MiB, WS_ACT = 503 * MiB, WS_SLOT = 50 * MiB;
constexpr size_t WS_END = 990 * MiB;
static_assert(WS_ROWW + 327680 <= WS_WIN && WS_WIN + (size_t)NPROJ * 1024 * 2 <= WS_WPE && WS_DT + (size_t)MROWS * 32 * 4 <= WS_ACS && WS_ACS + (size_t)BATCH * HEADS * PADLEN * 4 <= WS_DTC && WS_DTC + (size_t)BATCH * HEADS * PADLEN * 4 <= WS_XN, "map 1");
static_assert(WS_XN + (size_t)MROWS * 1024 * 2 <= WS_U && WS_U + (size_t)MROWS * 1024 * 2 <= WS_Z && WS_Z + (size_t)MROWS * 2048 * 2 <= WS_XBC && WS_XBC + (size_t)MROWS * 3072 * 2 <= WS_GATE && WS_GATE + (size_t)MROWS * 2048 * 2 <= WS_D && WS_D + (size_t)TOK * 1024 * 2 <= WS_XST, "map 2");
static_assert(WS_XST + (size_t)BATCH * HEADS * HD * PADLEN * 2 <= WS_BT && WS_BT + (size_t)BATCH * GROUPS * NSTATE * PADLEN * 2 <= WS_CN && WS_CN + (size_t)BATCH * PADLEN * 512 * 2 <= WS_G && WS_G + (size_t)BATCH * NCH * GROUPS * 128 * 128 * 2 <= WS_MERGED, "map 3");
static_assert(WS_Y + (size_t)TOK * 2048 * 2 <= WS_Z && WS_YN + (size_t)TOK * 2048 * 2 <= WS_TMP && WS_TMP + (size_t)TOK * 1024 * 2 <= WS_GATE && WS_WGU + (size_t)NEXP * 1024 * 1024 * 2 <= WS_WDN && WS_WDN + (size_t)NEXP * 1024 * 512 * 2 <= WS_G, "map 4");
static_assert(WS_H2 + (size_t)TOK * 1024 * 4 <= WS_XBC && WS_XS + (size_t)MAXBLK * 256 * 1024 * 2 <= WS_GATE && WS_ACT + (size_t)MAXBLK * 256 * 512 * 2 <= WS_D && WS_SLOT + (size_t)2 * TOK * 1024 * 2 <= WS_Z && WS_MERGED + (size_t)TOK * 1024 * 2 <= WS_END, "map 5");
constexpr int CW_TMO = 0, CW_CODE = 1, CW_BAR = 4096, CW_CNT = 8192;

constexpr int RING_BYTES = 131072;
constexpr int LDSCTL_OFF = RING_BYTES;
constexpr int MISC_OFF = LDSCTL_OFF + 320;
constexpr int TBL_OFF = LDSCTL_OFF + 1024;
constexpr int PST_OFF = TBL_OFF + 1536;
constexpr int LDS_BYTES = 147456;
static_assert(PST_OFF + 272 <= LDS_BYTES, "LDS map");

#define GAS __attribute__((address_space(1)))
#define LAS __attribute__((address_space(3)))
typedef unsigned short bf16;
typedef unsigned v4u __attribute__((ext_vector_type(4)));
typedef unsigned v2u __attribute__((ext_vector_type(2)));
typedef float f32x4 __attribute__((ext_vector_type(4)));
typedef short bf16x8 __attribute__((ext_vector_type(8)));
typedef GAS unsigned gu32;
#define RLX_AGENT __ATOMIC_RELAXED, __HIP_MEMORY_SCOPE_AGENT
#define LDS_WAIT() asm volatile("s_waitcnt lgkmcnt(0)" ::: "memory")
#define VM_WAIT() asm volatile("s_waitcnt vmcnt(0)" ::: "memory")
__device__ __forceinline__ unsigned f2bf(float f) { unsigned u = __builtin_bit_cast(unsigned, f); return (u + 0x7fffu + ((u >> 16) & 1u)) >> 16; }
__device__ __forceinline__ unsigned pk2(float lo, float hi) { return pg8::cvt_pk_bf16(lo, hi); }
__device__ __forceinline__ float bflo(unsigned w) { return __uint_as_float(w << 16); }
__device__ __forceinline__ float bfhi(unsigned w) { return __uint_as_float(w & 0xffff0000u); }
__device__ __forceinline__ float wave_sum(float v) {
#pragma unroll
    for (int o = 1; o < 64; o <<= 1) v += __shfl_xor(v, o);
    return v;
}

#define XB_TMO      128
#define XB_XCNT(j)  (256  + 64 * (j))
#define XB_XSUB(j)  (1280 + 64 * (j))
#define XB_XGEN(j)  (2304 + 64 * (j))
#define XB_TOP      3328
#define XB_TOPGEN   3392
#define XCD_BAR_WORDS 3456
#define XB_SPIN_CAP (1u << 18)

__device__ __forceinline__ unsigned xb_ld(unsigned* p)              { return __hip_atomic_load(p, __ATOMIC_RELAXED, __HIP_MEMORY_SCOPE_AGENT); }
__device__ __forceinline__ unsigned xb_add(unsigned* p, unsigned v) { return __hip_atomic_fetch_add(p, v, __ATOMIC_RELAXED, __HIP_MEMORY_SCOPE_AGENT); }
__device__ __forceinline__ unsigned xb_xcc_id() { return (unsigned)__builtin_amdgcn_s_getreg((3 << 11) | 20) & 0xFu; }
#define XB_SPIN(cond, bar) do { unsigned _sp = 0; while (cond) { __builtin_amdgcn_s_sleep(1); \
    if ((++_sp & 255u) == 0u) { if (xb_ld(&(bar)[XB_TMO])) break; if (_sp > XB_SPIN_CAP) { atomicAdd(&(bar)[XB_TMO], 1u); break; } } } } while (0)

struct XcdBarrier {
    unsigned* bar; unsigned x;
    volatile LAS unsigned* st;
};

__device__ __forceinline__ XcdBarrier xcd_barrier_post(unsigned* bar, volatile LAS unsigned* st) {
    XcdBarrier b; b.bar = bar; b.x = xb_xcc_id(); b.st = st;
    if (threadIdx.x == 0) (void)xb_add(&bar[XB_XCNT(b.x)], 1u);
    return b;
}
__device__ __forceinline__ void xcd_barrier_complete(unsigned* bar, unsigned x, unsigned& nloc, unsigned& nx) {
    const unsigned G = gridDim.x * gridDim.y * gridDim.z;
    unsigned sum, cnt, mine, sp = 0u;
    for (;;) {
        sum = 0u; cnt = 0u; mine = 0u;
#pragma unroll
        for (unsigned j = 0; j < 16; ++j) { const unsigned c = xb_ld(&bar[XB_XCNT(j)]); sum += c; cnt += (c > 0u) ? 1u : 0u; mine = (j == x) ? c : mine; }
        if (sum == G) break;
        __builtin_amdgcn_s_sleep(1);
        if ((++sp & 255u) == 0u) { if (xb_ld(&bar[XB_TMO])) break; if (sp > XB_SPIN_CAP) { atomicAdd(&bar[XB_TMO], 1u); break; } }
    }
    nloc = mine > 0u ? mine : 1u; nx = cnt > 0u ? cnt : 1u;
}

__device__ __forceinline__ void xcd_barrier(const XcdBarrier& b) {
    asm volatile("s_waitcnt vmcnt(0)" ::: "memory");
    __syncthreads();
    if (threadIdx.x == 0) {
        unsigned* bar = b.bar;
        __builtin_amdgcn_s_waitcnt(0);
        unsigned nloc = b.st[0], nx = b.st[1];
        if (nloc == 0u) { xcd_barrier_complete(bar, b.x, nloc, nx); b.st[0] = nloc; b.st[1] = nx; }
        const unsigned old = xb_add(&bar[XB_XSUB(b.x)], 1u);
        const unsigned gen = old / nloc;
        if (old + 1u == (gen + 1u) * nloc) {
            __builtin_amdgcn_fence(__ATOMIC_RELEASE, "agent");
            asm volatile("s_waitcnt vmcnt(0)" ::: "memory");
            const unsigned og = xb_add(&bar[XB_TOP], 1u);
            const unsigned tg = og / nx;
            if (og + 1u == (tg + 1u) * nx) xb_add(&bar[XB_TOPGEN], 1u);
            else XB_SPIN(xb_ld(&bar[XB_TOPGEN]) == tg, bar);
            __builtin_amdgcn_fence(__ATOMIC_ACQUIRE, "agent");
            xb_add(&bar[XB_XGEN(b.x)], 1u);
            asm volatile("s_waitcnt vmcnt(0)" ::: "memory");
        } else {
            XB_SPIN(xb_ld(&bar[XB_XGEN(b.x)]) == gen, bar);
            __builtin_amdgcn_fence(__ATOMIC_ACQUIRE, "agent");
            asm volatile("s_waitcnt vmcnt(0)" ::: "memory");
        }
    }
    __syncthreads();
}


struct Params {
    const float *x, *meta, *norm_mix, *w_in, *pool_w, *pool_scale, *conv_w, *conv_b, *dt_bias, *a_log, *d_skip, *ssd_norm, *w_pool_out, *w_ssd_out, *w_out, *norm_ffn,
                *w_rg, *b_rg, *w_re, *b_re, *w_gu, *w_dn, *norm_final;
    float* out; unsigned char* ws; int ph_lo, ph_hi;
};

struct Frame {
    LAS unsigned char* lds; volatile LAS unsigned* MISC; gu32* ctl;
    int tid, lane, wave, vcu, G;
};

__device__ __forceinline__ int seq_row(int b, int s) { return s < NMETA ? METAROW + s : b * SEQ + s - NMETA; }

__device__ __forceinline__ void transpose_item(const float* src, int ldw, bf16* dst, int ldk, LAS float* scr, int lane) {
#pragma unroll 8
    for (int i = 0; i < 32; ++i) { const int kk = 2 * i + (lane >> 5); scr[kk * 33 + (lane & 31)] = src[(size_t)kk * ldw + (lane & 31)]; }
    LDS_WAIT(); asm volatile("" ::: "memory");
    const int c = lane & 7;
#pragma unroll
    for (int j = 0; j < 4; ++j) { const int n = (lane >> 3) + 8 * j; const LAS float* s = scr + (8 * c) * 33 + n;
        v4u o; o.x = pk2(s[0 * 33], s[1 * 33]); o.y = pk2(s[2 * 33], s[3 * 33]); o.z = pk2(s[4 * 33], s[5 * 33]); o.w = pk2(s[6 * 33], s[7 * 33]);
        *(GAS v4u*)(dst + (size_t)n * ldk + 8 * c) = o; }
    LDS_WAIT(); asm volatile("" ::: "memory");
}
__device__ __forceinline__ void rms_row_to_bf16(const float* xrow, const float* gain, bf16* orow, int lane) {
    const GAS f32x4* xr = (const GAS f32x4*)xrow + lane; const GAS f32x4* gr = (const GAS f32x4*)gain + lane;
    f32x4 v[4]; float s = 0.f;
#pragma unroll
    for (int j = 0; j < 4; ++j) { v[j] = xr[64 * j]; s += (v[j].x * v[j].x + v[j].y * v[j].y) + (v[j].z * v[j].z + v[j].w * v[j].w); }
    const float rstd = 1.0f / sqrtf(wave_sum(s) * (1.f / 1024.f) + EPS);
    GAS v2u* o8 = (GAS v2u*)orow + lane;
#pragma unroll
    for (int j = 0; j < 4; ++j) { const f32x4 g = gr[64 * j]; v2u o; o.x = pk2(v[j].x * rstd * g.x, v[j].y * rstd * g.y); o.y = pk2(v[j].z * rstd * g.z, v[j].w * rstd * g.w); o8[64 * j] = o; }
}
__device__ __forceinline__ void moe_weight_items(const Params& p, Frame& F, LAS float* scr, int first, int stride) {
    constexpr int I_GU = NEXP * 16 * 32, I_DN = NEXP * 8 * 32;
    bf16* WGU = (bf16*)(p.ws + WS_WGU); bf16* WDN = (bf16*)(p.ws + WS_WDN);
    for (int it = first; it < I_GU + I_DN; it += stride) {
        if (it < I_GU) { const int e = it >> 9, r = it & 511, kb = r >> 5, nb = r & 31, n0 = nb * 32, k0 = kb * 64;
            const int drow = ((n0 & 511) >> 7) * 256 + (n0 >= 512 ? 128 : 0) + (n0 & 127);
            transpose_item(p.w_gu + (size_t)e * 1024 * 1024 + (size_t)k0 * 1024 + n0, 1024, WGU + (size_t)e * 1024 * 1024 + (size_t)drow * 1024 + k0, 1024, scr, F.lane); }
        else { const int q = it - I_GU, e = q >> 8, r = q & 255, kb = r >> 5, nb = r & 31, n0 = nb * 32, k0 = kb * 64;
            transpose_item(p.w_dn + (size_t)e * 512 * 1024 + (size_t)k0 * 1024 + n0, 1024, WDN + (size_t)e * 1024 * 512 + (size_t)n0 * 512 + k0, 512, scr, F.lane); }
    }
}

__device__ __forceinline__ void p0_prologue(const Params& p, Frame& F) {
    LAS float* scr = (LAS float*)(F.lds + F.wave * 16384);
    bf16* WIN = (bf16*)(p.ws + WS_WIN); bf16* WPE = (bf16*)(p.ws + WS_WPE); bf16* WSO = (bf16*)(p.ws + WS_WSO); bf16* WOUT = (bf16*)(p.ws + WS_WOUT); bf16* WR = (bf16*)(p.ws + WS_WR);
    bf16* XN = (bf16*)(p.ws + WS_XN);
    for (int it = F.vcu; it < 256; it += F.G) {
        const int rt = it >> 4, ct = it & 15, q = rt >> 2, r0 = (rt & 3) * 64, n0 = ct * 64;
        LAS float* As = (LAS float*)F.lds; LAS float* Bs = As + 64 * 33;
        const int ty = F.tid >> 4, tx = F.tid & 15;
        float acc[2][4] = {{0.f, 0.f, 0.f, 0.f}, {0.f, 0.f, 0.f, 0.f}};
        for (int m0 = 0; m0 < 256; m0 += 32) {
            __syncthreads();
#pragma unroll
            for (int i = 0; i < 4; ++i) { const int idx = F.tid + 512 * i, rr = idx >> 5, mm = idx & 31;
                As[rr * 33 + mm] = p.pool_w[((size_t)q * 256 + r0 + rr) * 256 + m0 + mm] * p.pool_scale[q * 256 + m0 + mm];
                const int bm = idx >> 6, bn = idx & 63;
                Bs[bm * 65 + bn] = p.w_pool_out[(size_t)(q * 256 + m0 + bm) * 1024 + n0 + bn]; }
            __syncthreads();
#pragma unroll 8
            for (int mm = 0; mm < 32; ++mm) { const float a0 = As[(2 * ty) * 33 + mm], a1 = As[(2 * ty + 1) * 33 + mm];
#pragma unroll
                for (int j = 0; j < 4; ++j) { const float bv = Bs[mm * 65 + 4 * tx + j]; acc[0][j] += a0 * bv; acc[1][j] += a1 * bv; } }
        }
#pragma unroll
        for (int i = 0; i < 2; ++i)
#pragma unroll
            for (int j = 0; j < 4; ++j) WPE[(size_t)(n0 + 4 * tx + j) * 1024 + q * 256 + r0 + 2 * ty + i] = (bf16)f2bf(acc[i][j]);
        __syncthreads();
    }
    const int gw = F.vcu * NWAVES + F.wave, NGW = F.G * NWAVES;
    constexpr int I_IN = 16 * 257, I_SO = 32 * 32, I_OUT = 16 * 32;
    for (int it = gw; it < I_IN + I_SO + I_OUT; it += NGW) {
        int r = it;
        if (r < I_IN) { const int kb = r / 257, nb = r % 257, n0 = nb * 32, k0 = kb * 64;
            const int drow = n0 < 6144 ? n0 : (n0 < 6176 ? 8192 + (n0 - 6144) : n0 - 32);
            transpose_item(p.w_in + (size_t)k0 * DIN + n0, DIN, WIN + (size_t)drow * 1024 + k0, 1024, scr, F.lane); continue; }
        r -= I_IN;
        if (r < I_SO) { const int kb = r >> 5, nb = r & 31; transpose_item(p.w_ssd_out + (size_t)kb * 64 * 1024 + nb * 32, 1024, WSO + (size_t)nb * 32 * 2048 + kb * 64, 2048, scr, F.lane); continue; }
        r -= I_SO;
        { const int kb = r >> 5, nb = r & 31; transpose_item(p.w_out + (size_t)kb * 64 * 1024 + nb * 32, 1024, WOUT + (size_t)nb * 32 * 1024 + kb * 64, 1024, scr, F.lane); }
    }
    for (size_t i = (size_t)(F.vcu * NTHR + F.tid); i < (size_t)(NPROJ - DIN) * 1024 / 8; i += (size_t)F.G * NTHR) ((GAS v4u*)(WIN + (size_t)DIN * 1024))[i] = (v4u){0u, 0u, 0u, 0u};
    for (int i = F.vcu * NTHR + F.tid; i < 256 * 1024; i += F.G * NTHR) { const int n = i >> 10, k = i & 1023;
        const float v = n < 8 ? p.w_rg[k * 8 + n] : (n < 72 ? p.w_re[k * 64 + n - 8] : 0.f); WR[i] = (bf16)f2bf(v); }
    for (int m = gw; m < MROWS; m += NGW) {
        if (m < TOK) rms_row_to_bf16(p.x + (size_t)m * 1024, p.norm_mix, XN + (size_t)m * 1024, F.lane);
        else if (m < TOK + NMETA) rms_row_to_bf16(p.meta + (size_t)(m - TOK) * 1024, p.norm_mix, XN + (size_t)m * 1024, F.lane);
        else { GAS v4u* o = (GAS v4u*)(XN + (size_t)m * 1024) + F.lane; o[0] = (v4u){0u, 0u, 0u, 0u}; o[64] = (v4u){0u, 0u, 0u, 0u}; }
    }
}

__device__ __forceinline__ void unpack8(const v4u w, float (&f)[8]) { f[0] = bflo(w.x); f[1] = bfhi(w.x); f[2] = bflo(w.y); f[3] = bfhi(w.y); f[4] = bflo(w.z); f[5] = bfhi(w.z); f[6] = bflo(w.w); f[7] = bfhi(w.w); }

__device__ __forceinline__ void prep_conv_item(const Params& p, Frame& F, int b, int c, int slab) {
    const bf16* XBC = (const bf16*)(p.ws + WS_XBC);
    bf16* XST = (bf16*)(p.ws + WS_XST); bf16* BT = (bf16*)(p.ws + WS_BT); bf16* CN = (bf16*)(p.ws + WS_CN); bf16* GM = (bf16*)(p.ws + WS_G);
    const int cg = F.tid & 31, rseg = F.tid >> 5, l0 = rseg * 8, P0 = c * CHUNK;
    const bool bc = slab >= 8; const int g = slab - 8;
    const int ch = !bc ? slab * 256 + cg * 8 : (cg < 16 ? 2048 + g * 128 + cg * 8 : 2560 + g * 128 + (cg - 16) * 8);
    v4u on[8];
    {
        float wk[4][8], bias[8];
#pragma unroll
        for (int k = 0; k < 4; ++k) { const f32x4 a = *(const GAS f32x4*)(p.conv_w + k * CONVD + ch), b2 = *(const GAS f32x4*)(p.conv_w + k * CONVD + ch + 4);
            wk[k][0] = a.x; wk[k][1] = a.y; wk[k][2] = a.z; wk[k][3] = a.w; wk[k][4] = b2.x; wk[k][5] = b2.y; wk[k][6] = b2.z; wk[k][7] = b2.w; }
        { const f32x4 a = *(const GAS f32x4*)(p.conv_b + ch), b2 = *(const GAS f32x4*)(p.conv_b + ch + 4);
            bias[0] = a.x; bias[1] = a.y; bias[2] = a.z; bias[3] = a.w; bias[4] = b2.x; bias[5] = b2.y; bias[6] = b2.z; bias[7] = b2.w; }
        v4u xr[11];
#pragma unroll
        for (int r = 0; r < 11; ++r) { const int s = P0 + l0 + r - 3 - 112;
            xr[r] = (s >= 0) ? *(const GAS v4u*)(XBC + (size_t)seq_row(b, s) * CONVD + ch) : (v4u){0u, 0u, 0u, 0u}; }
#pragma unroll
        for (int j = 0; j < 8; ++j) {
            float a[8];
#pragma unroll
            for (int i = 0; i < 8; ++i) a[i] = bias[i];
#pragma unroll
            for (int k = 0; k < 4; ++k) { float xf[8]; unpack8(xr[j + k], xf);
#pragma unroll
                for (int i = 0; i < 8; ++i) a[i] += wk[k][i] * xf[i]; }
            const bool valid = (P0 + l0 + j - 112) >= 0;
#pragma unroll
            for (int i = 0; i < 8; ++i) a[i] = valid ? pg8::silu_f(a[i]) : 0.f;
            on[j] = (v4u){pk2(a[0], a[1]), pk2(a[2], a[3]), pk2(a[4], a[5]), pk2(a[6], a[7])};
        }
    }
    LAS unsigned char* T = F.lds;
    LAS unsigned char* TT = bc ? F.lds + 69632 : F.lds;
    if (!bc || cg < 16) {
#pragma unroll
        for (int i = 0; i < 8; ++i) {
            const int q = i >> 1; v4u t;
            unsigned e[8];
#pragma unroll
            for (int j = 0; j < 8; ++j) { const unsigned w = q == 0 ? on[j].x : (q == 1 ? on[j].y : (q == 2 ? on[j].z : on[j].w)); e[j] = (i & 1) ? (w >> 16) : (w & 0xffffu); }
            t.x = e[0] | (e[1] << 16); t.y = e[2] | (e[3] << 16); t.z = e[4] | (e[5] << 16); t.w = e[6] | (e[7] << 16);
            const int chl = cg * 8 + i;
            *(LAS v4u*)(TT + chl * 256 + ((rseg ^ (cg & 15)) << 4)) = t;
        }
    }
    if (bc) {
#pragma unroll
        for (int j = 0; j < 8; ++j) *(LAS v4u*)(T + (l0 + j) * 528 + cg * 16) = on[j];
        if (cg >= 16) {
#pragma unroll
            for (int j = 0; j < 8; ++j) *(GAS v4u*)(CN + ((size_t)(b * PADLEN + P0 + l0 + j) * 4 + g) * 128 + (cg - 16) * 8) = on[j];
        }
    }
    __syncthreads();
    if (!bc) {
#pragma unroll
        for (int i = 0; i < 8; ++i) { const int v = F.tid + 512 * i, lg = v & 15, chl = v >> 4, h = slab * 4 + (chl >> 6), pp = chl & 63;
            const v4u t = *(const LAS v4u*)(TT + chl * 256 + ((lg ^ ((chl >> 3) & 15)) << 4));
            *(GAS v4u*)(XST + ((size_t)(b * HEADS + h) * HD + pp) * PADLEN + P0 + 8 * lg) = t; }
    } else {
#pragma unroll
        for (int i = 0; i < 4; ++i) { const int v = F.tid + 512 * i, lg = v & 15, n = v >> 4;
            const v4u t = *(const LAS v4u*)(TT + n * 256 + ((lg ^ ((n >> 3) & 15)) << 4));
            *(GAS v4u*)(BT + ((size_t)(b * GROUPS + g) * NSTATE + n) * PADLEN + P0 + 8 * lg) = t; }
        if (c >= 1) {
            const int w = F.wave, fr = F.lane & 15, fq = F.lane >> 4;
            bf16x8 Cf[4];
#pragma unroll
            for (int ks = 0; ks < 4; ++ks) Cf[ks] = *(const LAS bf16x8*)(T + (16 * w + fr) * 528 + (128 + 32 * ks + 8 * fq) * 2);
            bf16* Gp = GM + ((size_t)((b * NCH + c) * GROUPS + g) * 128 + 16 * w + fr) * 128;
            for (int st = 0; st <= w; ++st) {
                f32x4 acc = (f32x4){0.f, 0.f, 0.f, 0.f};
#pragma unroll
                for (int ks = 0; ks < 4; ++ks) { const bf16x8 Bf = *(const LAS bf16x8*)(T + (16 * st + fr) * 528 + (32 * ks + 8 * fq) * 2);
                    acc = __builtin_amdgcn_mfma_f32_16x16x32_bf16(Bf, Cf[ks], acc, 0, 0, 0); }
                v2u o; o.x = pk2(acc[0], acc[1]); o.y = pk2(acc[2], acc[3]);
                *(GAS v2u*)(Gp + 16 * st + 4 * fq) = o;
            }
        }
    }
    __syncthreads();
}
__device__ __forceinline__ void prep_pool_item(const Params& p, Frame& F, int b, int c) {
    const bf16* U = (const bf16*)(p.ws + WS_U); bf16* D = (bf16*)(p.ws + WS_D);
    const int cgp = F.tid & 127, rs = F.tid >> 7, ch = cgp * 8, w = 2 << (cgp >> 5);
    const int t0 = (c - 1) * CHUNK + rs * 32, s0 = t0 + NMETA;
    float sum[8];
#pragma unroll
    for (int i = 0; i < 8; ++i) sum[i] = 0.f;
    for (int j = 1; j < w; ++j) { float f[8]; unpack8(*(const GAS v4u*)(U + (size_t)seq_row(b, s0 - j) * 1024 + ch), f);
#pragma unroll
        for (int i = 0; i < 8; ++i) sum[i] += f[i]; }
    const float inv = 1.0f / (float)w;
    for (int r = 0; r < 32; ++r) { const int s = s0 + r; float cur[8], old[8], d[8];
        unpack8(*(const GAS v4u*)(U + (size_t)seq_row(b, s) * 1024 + ch), cur);
        unpack8(*(const GAS v4u*)(U + (size_t)seq_row(b, s - w + 1) * 1024 + ch), old);
#pragma unroll
        for (int i = 0; i < 8; ++i) { sum[i] += cur[i]; d[i] = sum[i] * inv - cur[i]; sum[i] -= old[i]; }
        *(GAS v4u*)(D + (size_t)(b * SEQ + t0 + r) * 1024 + ch) = (v4u){pk2(d[0], d[1]), pk2(d[2], d[3]), pk2(d[4], d[5]), pk2(d[6], d[7])}; }
}
__device__ __forceinline__ void prep_dt_item(const Params& p, Frame& F, int b, int c) {
    const float* DT = (const float*)(p.ws + WS_DT); float* ACS = (float*)(p.ws + WS_ACS); float* DTC = (float*)(p.ws + WS_DTC);
    LAS float* al = (LAS float*)F.lds; LAS float* dl = al + 128 * 33;
    for (int idx = F.tid; idx < 4096; idx += NTHR) { const int l = idx >> 5, h = idx & 31, s = c * CHUNK + l - 112;
        const float dt = s >= 0 ? DT[(size_t)seq_row(b, s) * 32 + h] : 0.f;
        dl[l * 33 + h] = dt; al[l * 33 + h] = dt * (-__expf(p.a_log[h])); }
    __syncthreads();
    if (F.tid < 32) { float run = 0.f; for (int l = 0; l < 128; ++l) { run += al[l * 33 + F.tid]; al[l * 33 + F.tid] = run; } }
    __syncthreads();
    for (int idx = F.tid; idx < 4096; idx += NTHR) { const int h = idx >> 7, l = idx & 127; const size_t o = (size_t)(b * HEADS + h) * PADLEN + c * CHUNK + l;
        ACS[o] = al[l * 33 + h]; DTC[o] = dl[l * 33 + h]; }
    __syncthreads();
}
__device__ __forceinline__ void p2_prep(const Params& p, Frame& F) {
    constexpr int I_A = BATCH * NCH * 12, I_B = BATCH * 64, I_C = BATCH * NCH;
    for (int it = F.vcu; it < I_A + I_B + I_C; it += F.G) {
        if (it < I_A) { const int slab = it % 12, bc = it / 12; prep_conv_item(p, F, bc / NCH, bc % NCH, slab); }
        else if (it < I_A + I_B) { const int q = it - I_A; prep_pool_item(p, F, q >> 6, (q & 63) + 1); }
        else { const int q = it - I_A - I_B; prep_dt_item(p, F, q / NCH, q % NCH); }
    }
}

constexpr int WK_XS = 0, WK_X2 = 8704, WK_BT = 17408, WK_AC = 52224, WK_DT = 52736, WK_BUF = 53248, WK_SBF = 2 * WK_BUF, WK_SBFSZ = 8704;
static_assert(WK_SBF + 2 * WK_SBFSZ <= RING_BYTES, "walk LDS");
__device__ __forceinline__ void ssd_walk_item(const Params& p, Frame& F, int b, int h, int ph) {
    const int g = h >> 3, w = F.wave, fr = F.lane & 15, fq = F.lane >> 4, tid = F.tid;
    const bf16* XST = (const bf16*)(p.ws + WS_XST); const bf16* BT = (const bf16*)(p.ws + WS_BT); const bf16* CN = (const bf16*)(p.ws + WS_CN); const bf16* GM = (const bf16*)(p.ws + WS_G);
    const float* ACS = (const float*)(p.ws + WS_ACS) + (size_t)(b * HEADS + h) * PADLEN; const float* DTC = (const float*)(p.ws + WS_DTC) + (size_t)(b * HEADS + h) * PADLEN;
    bf16* Y = (bf16*)(p.ws + WS_Y);
    const float Dh = p.d_skip[h];
    const int xp = tid >> 4, xlg = tid & 15;
    const bf16* xsrc = XST + ((size_t)(b * HEADS + h) * HD + 32 * ph + xp) * PADLEN + 8 * xlg;
    const bf16* bsrc = BT + ((size_t)(b * GROUPS + g) * NSTATE + (tid >> 4)) * PADLEN + 8 * xlg;
    const bf16* gsrc = GM + ((size_t)(b * NCH * GROUPS + g) * 128 + 16 * w + fr) * 128 + 8 * fq;
    const bf16* csrc = CN + ((size_t)(b * PADLEN + 16 * w + fr) * 4 + g) * 128 + 8 * fq;
    v4u xv, btv[4], Gn[4], Cn4[4], Gc[4], Cc[4]; f32x4 acs8a, acs8b, dt8a, dt8b; float acend, ldsv = 0.f;
#define WK_LOAD(c_) do { const int c__ = (c_); xv = *(const GAS v4u*)(xsrc + c__ * CHUNK); \
        _Pragma("unroll") for (int i = 0; i < 4; ++i) btv[i] = *(const GAS v4u*)(bsrc + (size_t)i * 32 * PADLEN + c__ * CHUNK); \
        acs8a = *(const GAS f32x4*)(ACS + c__ * CHUNK + 8 * xlg); acs8b = *(const GAS f32x4*)(ACS + c__ * CHUNK + 8 * xlg + 4); \
        dt8a = *(const GAS f32x4*)(DTC + c__ * CHUNK + 8 * xlg); dt8b = *(const GAS f32x4*)(DTC + c__ * CHUNK + 8 * xlg + 4); acend = ACS[c__ * CHUNK + 127]; \
        if (tid < 128) ldsv = ACS[c__ * CHUNK + tid]; else if (tid < 256) ldsv = DTC[c__ * CHUNK + tid - 128]; \
        _Pragma("unroll") for (int ks = 0; ks < 4; ++ks) { Gn[ks] = *(const GAS v4u*)(gsrc + (size_t)c__ * GROUPS * 128 * 128 + 32 * ks); Cn4[ks] = *(const GAS v4u*)(csrc + (size_t)c__ * CHUNK * 512 + 32 * ks); } } while (0)
#define WK_STORE(buf_) do { LAS unsigned char* B_ = F.lds + (buf_) * WK_BUF; \
        *(LAS v4u*)(B_ + WK_XS + xp * 272 + xlg * 16) = xv; \
        { float xf[8]; unpack8(xv, xf); const float wl[8] = {dt8a.x * __expf(acend - acs8a.x), dt8a.y * __expf(acend - acs8a.y), dt8a.z * __expf(acend - acs8a.z), dt8a.w * __expf(acend - acs8a.w), \
                                                           dt8b.x * __expf(acend - acs8b.x), dt8b.y * __expf(acend - acs8b.y), dt8b.z * __expf(acend - acs8b.z), dt8b.w * __expf(acend - acs8b.w)}; \
          *(LAS v4u*)(B_ + WK_X2 + xp * 272 + xlg * 16) = (v4u){pk2(xf[0] * wl[0], xf[1] * wl[1]), pk2(xf[2] * wl[2], xf[3] * wl[3]), pk2(xf[4] * wl[4], xf[5] * wl[5]), pk2(xf[6] * wl[6], xf[7] * wl[7])}; } \
        _Pragma("unroll") for (int i = 0; i < 4; ++i) *(LAS v4u*)(B_ + WK_BT + ((tid >> 4) + 32 * i) * 272 + xlg * 16) = btv[i]; \
        if (tid < 128) *(LAS float*)(B_ + WK_AC + tid * 4) = ldsv; else if (tid < 256) *(LAS float*)(B_ + WK_DT + (tid - 128) * 4) = ldsv; \
        _Pragma("unroll") for (int ks = 0; ks < 4; ++ks) { Gc[ks] = Gn[ks]; Cc[ks] = Cn4[ks]; } } while (0)
    for (int i = tid; i < WK_SBFSZ / 16; i += NTHR) *(LAS v4u*)(F.lds + WK_SBF + i * 16) = (v4u){0u, 0u, 0u, 0u};
    WK_LOAD(0); WK_STORE(0);
    __syncthreads();
    f32x4 accS[2] = {(f32x4){0.f, 0.f, 0.f, 0.f}, (f32x4){0.f, 0.f, 0.f, 0.f}};
    const int lrow = 16 * w + fr, kmax = (16 * w + 15) >> 5;
    for (int c = 0; c < NCH; ++c) {
        if (c + 1 < NCH) WK_LOAD(c + 1);
        const LAS unsigned char* B_ = F.lds + (c & 1) * WK_BUF;
        const LAS unsigned char* SB = F.lds + WK_SBF + (c & 1) * WK_SBFSZ;
        LAS unsigned char* SBn = F.lds + WK_SBF + ((c + 1) & 1) * WK_SBFSZ;
        const LAS float* AC = (const LAS float*)(B_ + WK_AC); const LAS float* DL = (const LAS float*)(B_ + WK_DT);
        if (c >= 1) {
            f32x4 acc[2] = {(f32x4){0.f, 0.f, 0.f, 0.f}, (f32x4){0.f, 0.f, 0.f, 0.f}};
            const float acs_l = AC[lrow];
#pragma unroll
            for (int ks = 0; ks < 4; ++ks) {
                if (ks <= kmax) {
                    const int s0 = 32 * ks + 8 * fq; float gv[8]; unpack8(Gc[ks], gv);
                    const f32x4 a0 = *(const LAS f32x4*)(AC + s0), a1 = *(const LAS f32x4*)(AC + s0 + 4), d0 = *(const LAS f32x4*)(DL + s0), d1 = *(const LAS f32x4*)(DL + s0 + 4);
                    const float as[8] = {a0.x, a0.y, a0.z, a0.w, a1.x, a1.y, a1.z, a1.w}, ds[8] = {d0.x, d0.y, d0.z, d0.w, d1.x, d1.y, d1.z, d1.w};
                    float sv[8];
#pragma unroll
                    for (int j = 0; j < 8; ++j) { const int s = s0 + j; float v = (s <= lrow) ? gv[j] * __expf(acs_l - as[j]) * ds[j] : 0.f; if (s == lrow) v += Dh; sv[j] = v; }
                    v4u sp = (v4u){pk2(sv[0], sv[1]), pk2(sv[2], sv[3]), pk2(sv[4], sv[5]), pk2(sv[6], sv[7])};
                    const bf16x8 Sf = __builtin_bit_cast(bf16x8, sp);
#pragma unroll
                    for (int pt = 0; pt < 2; ++pt) { const bf16x8 Xf = *(const LAS bf16x8*)(B_ + WK_XS + (16 * pt + fr) * 272 + (32 * ks + 8 * fq) * 2);
                        acc[pt] = __builtin_amdgcn_mfma_f32_16x16x32_bf16(Xf, Sf, acc[pt], 0, 0, 0); }
                }
            }
            const float ea = __expf(acs_l);
#pragma unroll
            for (int ks = 0; ks < 4; ++ks) { float cv[8]; unpack8(Cc[ks], cv);
                v4u cp = (v4u){pk2(cv[0] * ea, cv[1] * ea), pk2(cv[2] * ea, cv[3] * ea), pk2(cv[4] * ea, cv[5] * ea), pk2(cv[6] * ea, cv[7] * ea)};
                const bf16x8 Cf = __builtin_bit_cast(bf16x8, cp);
#pragma unroll
                for (int pt = 0; pt < 2; ++pt) { const bf16x8 Sfr = *(const LAS bf16x8*)(SB + (16 * pt + fr) * 272 + (32 * ks + 8 * fq) * 2);
                    acc[pt] = __builtin_amdgcn_mfma_f32_16x16x32_bf16(Sfr, Cf, acc[pt], 0, 0, 0); } }
            bf16* yrow = Y + (size_t)(b * SEQ + (c - 1) * CHUNK + lrow) * SSD_INNER + h * HD + 32 * ph + 4 * fq;
#pragma unroll
            for (int pt = 0; pt < 2; ++pt) { v2u o; o.x = pk2(acc[pt][0], acc[pt][1]); o.y = pk2(acc[pt][2], acc[pt][3]); *(GAS v2u*)(yrow + 16 * pt) = o; }
        }
        { const float alpha = __expf(AC[127]);
            accS[0] = accS[0] * alpha; accS[1] = accS[1] * alpha;
#pragma unroll
            for (int ks = 0; ks < 4; ++ks) { const bf16x8 Bf = *(const LAS bf16x8*)(B_ + WK_BT + (16 * w + fr) * 272 + (32 * ks + 8 * fq) * 2);
#pragma unroll
                for (int pt = 0; pt < 2; ++pt) { const bf16x8 X2f = *(const LAS bf16x8*)(B_ + WK_X2 + (16 * pt + fr) * 272 + (32 * ks + 8 * fq) * 2);
                    accS[pt] = __builtin_amdgcn_mfma_f32_16x16x32_bf16(Bf, X2f, accS[pt], 0, 0, 0); } }
#pragma unroll
            for (int pt = 0; pt < 2; ++pt) { v2u o; o.x = pk2(accS[pt][0], accS[pt][1]); o.y = pk2(accS[pt][2], accS[pt][3]);
                *(LAS v2u*)(SBn + (16 * pt + fr) * 272 + (16 * w + 4 * fq) * 2) = o; } }
        if (c + 1 < NCH) WK_STORE((c + 1) & 1);
        __syncthreads();
    }
#undef WK_LOAD
#undef WK_STORE
}

__device__ __forceinline__ void p4_gate_norm(const Params& p, Frame& F) {
    const bf16* Y = (const bf16*)(p.ws + WS_Y); const bf16* Z = (const bf16*)(p.ws + WS_Z); bf16* YN = (bf16*)(p.ws + WS_YN);
    const int gw = F.vcu * NWAVES + F.wave, NGW = F.G * NWAVES;
    for (int m = gw; m < TOK; m += NGW) {
#pragma unroll
        for (int j = 0; j < 4; ++j) { const int col = 512 * j + 8 * F.lane; float yf[8], zf[8], v[8];
            unpack8(*(const GAS v4u*)(Y + (size_t)m * 2048 + col), yf); unpack8(*(const GAS v4u*)(Z + (size_t)m * 2048 + col), zf);
            float ss = 0.f;
#pragma unroll
            for (int i = 0; i < 8; ++i) { v[i] = yf[i] * pg8::silu_f(zf[i]); ss += v[i] * v[i]; }
            const float rstd = 1.0f / sqrtf(wave_sum(ss) * (1.f / 512.f) + EPS);
            const f32x4 g0 = *(const GAS f32x4*)(p.ssd_norm + col), g1 = *(const GAS f32x4*)(p.ssd_norm + col + 4);
            *(GAS v4u*)(YN + (size_t)m * 2048 + col) = (v4u){pk2(v[0] * rstd * g0.x, v[1] * rstd * g0.y), pk2(v[2] * rstd * g0.z, v[3] * rstd * g0.w), pk2(v[4] * rstd * g1.x, v[5] * rstd * g1.y), pk2(v[6] * rstd * g1.z, v[7] * rstd * g1.w)}; }
    }
}

__device__ __forceinline__ void build_moe_tables(Frame& F) {
    LAS unsigned* TBL = (LAS unsigned*)(F.lds + TBL_OFF); LAS unsigned* PST = (LAS unsigned*)(F.lds + PST_OFF);
    if (F.wave == 0) {
        const unsigned cn = __hip_atomic_load(F.ctl + CW_CNT + F.lane, RLX_AGENT); const unsigned nb = (cn + 255u) >> 8;
        unsigned x = nb;
#pragma unroll
        for (int o = 1; o < 64; o <<= 1) { const unsigned y = __shfl_up(x, o); if (F.lane >= o) x += y; }
        const unsigned bstart = x - nb;
        PST[F.lane] = bstart * 256u;
        if (F.lane == 63) PST[64] = x;
        for (unsigned k = 0; k < nb; ++k) { const unsigned rem = cn - 256u * k; TBL[bstart + k] = (unsigned)F.lane | ((rem < 256u ? rem : 256u) << 8); }
    }
    __syncthreads();
}

__device__ __forceinline__ void p9_gather(const Params& p, Frame& F) {
    const int* asg_e = (const int*)(p.ws + WS_ASGE); const int* asg_pos = (const int*)(p.ws + WS_ASGP); const float* asg_w = (const float*)(p.ws + WS_ASGW);
    int* row_a = (int*)(p.ws + WS_ROWA); float* row_w = (float*)(p.ws + WS_ROWW);
    const bf16* H2N = (const bf16*)(p.ws + WS_H2N); bf16* XS = (bf16*)(p.ws + WS_XS);
    const LAS unsigned* PST = (const LAS unsigned*)(F.lds + PST_OFF);
    const int gw = F.vcu * NWAVES + F.wave, NGW = F.G * NWAVES;
    for (int a = gw; a < 2 * TOK; a += NGW) {
        const int e = asg_e[a], pos = asg_pos[a]; const int dest = (int)PST[e] + pos, tok = a >> 1;
        const GAS v4u* s = (const GAS v4u*)(H2N + (size_t)tok * 1024) + F.lane; GAS v4u* d = (GAS v4u*)(XS + (size_t)dest * 1024) + F.lane;
        const v4u a0 = s[0], a1 = s[64]; d[0] = a0; d[64] = a1;
        if (F.lane == 0) { row_a[dest] = a; row_w[dest] = asg_w[a]; }
    }
}
__device__ __forceinline__ void p12_final(const Params& p, Frame& F) {
    const float* H2 = (const float*)(p.ws + WS_H2); const bf16* SLOT = (const bf16*)(p.ws + WS_SLOT);
    const int gw = F.vcu * NWAVES + F.wave, NGW = F.G * NWAVES;
    for (int m = gw; m < TOK; m += NGW) {
        const GAS f32x4* hr = (const GAS f32x4*)(H2 + (size_t)m * 1024) + F.lane;
        const GAS v2u* s0 = (const GAS v2u*)(SLOT + (size_t)(2 * m) * 1024) + F.lane; const GAS v2u* s1 = (const GAS v2u*)(SLOT + (size_t)(2 * m + 1) * 1024) + F.lane;
        f32x4 v[4]; float ss = 0.f;
#pragma unroll
        for (int j = 0; j < 4; ++j) { v[j] = hr[64 * j]; const v2u a = s0[64 * j], c = s1[64 * j];
            v[j].x += bflo(a.x) + bflo(c.x); v[j].y += bfhi(a.x) + bfhi(c.x); v[j].z += bflo(a.y) + bflo(c.y); v[j].w += bfhi(a.y) + bfhi(c.y);
            ss += (v[j].x * v[j].x + v[j].y * v[j].y) + (v[j].z * v[j].z + v[j].w * v[j].w); }
        const float rstd = 1.0f / sqrtf(wave_sum(ss) * (1.f / 1024.f) + EPS);
        GAS f32x4* o = (GAS f32x4*)(p.out + (size_t)m * 1024) + F.lane; const GAS f32x4* gr = (const GAS f32x4*)p.norm_final + F.lane;
#pragma unroll
        for (int j = 0; j < 4; ++j) { const f32x4 g = gr[64 * j]; o[64 * j] = (f32x4){v[j].x * rstd * g.x, v[j].y * rstd * g.y, v[j].z * rstd * g.z, v[j].w * rstd * g.w}; }
    }
}

__global__ void __launch_bounds__(NTHR, 2) mk_fwd(Params p) {
    extern __shared__ __attribute__((aligned(16))) unsigned char lds[];
    Frame F;
    F.lds = (LAS unsigned char*)lds; F.MISC = (volatile LAS unsigned*)(F.lds + MISC_OFF);
    F.tid = threadIdx.x; F.lane = F.tid & 63; F.wave = __builtin_amdgcn_readfirstlane(F.tid >> 6);
    F.G = gridDim.x; { const int bx = blockIdx.x; F.vcu = (F.G % 8 == 0) ? (bx % 8) * (F.G / 8) + bx / 8 : bx; }
    F.ctl = (gu32*)(p.ws + WS_CTL);
    for (int u = F.tid; u < (LDS_BYTES - LDSCTL_OFF) / 4; u += NTHR) ((LAS unsigned*)(F.lds + LDSCTL_OFF))[u] = 0u;
    __syncthreads();
    const int lo = p.ph_lo, hi = p.ph_hi;
    XcdBarrier bar; bar.bar = (unsigned*)(F.ctl + CW_BAR); bar.x = 0; bar.st = nullptr;
    if (hi - lo > 1) bar = xcd_barrier_post((unsigned*)(F.ctl + CW_BAR), F.MISC + 8);
#define IN(k) (lo <= (k) && (k) < hi)
#define SEAM(k) do { if (IN(k) && IN((k) + 1)) xcd_barrier(bar); } while (0)
    LAS unsigned char* ring = F.lds;
    unsigned char* ws = p.ws;
    bf16* XN = (bf16*)(ws + WS_XN); bf16* U = (bf16*)(ws + WS_U); bf16* Z = (bf16*)(ws + WS_Z); bf16* XBC = (bf16*)(ws + WS_XBC); bf16* GATE = (bf16*)(ws + WS_GATE);

    if (IN(0)) { p0_prologue(p, F); }
    SEAM(0);
    if (IN(1)) {
        pg8::Gemm g{XN, (const bf16*)(ws + WS_WIN), MROWS, NPROJ, 1024}; pg8::StaticOrder S; S.init(MROWS, NPROJ, F.G, (int)blockIdx.x);
        pg8::EpiProj E{U, Z, XBC, GATE, (float*)(ws + WS_DT), p.dt_bias};
        pg8::gemm_phase<pg8::EpiProj, pg8::StaticOrder, true, true>(ring, g, S, E);
    }
    SEAM(1);
    if (IN(2)) { p2_prep(p, F); }
    SEAM(2);
    if (IN(3)) {
        for (int it = F.vcu; it < BATCH * HEADS * 2; it += F.G) { const int bg = it >> 4, inner = it & 15; ssd_walk_item(p, F, bg >> 2, (bg & 3) * 8 + (inner >> 1), inner & 1); }
        pg8::Gemm g{(const bf16*)(ws + WS_D), (const bf16*)(ws + WS_WPE), TOK, 1024, 1024}; pg8::StaticOrder S; S.init(TOK, 1024, F.G, (int)blockIdx.x);
        pg8::EpiGateMul E{GATE, 2048, nullptr, (bf16*)(ws + WS_TMP)};
        pg8::gemm_phase<pg8::EpiGateMul, pg8::StaticOrder, true, true>(ring, g, S, E);
    }
    SEAM(3);
    if (IN(4)) {
        p4_gate_norm(p, F);
        moe_weight_items(p, F, (LAS float*)(F.lds + F.wave * 16384), F.vcu * NWAVES + F.wave, F.G * NWAVES);
    }
    SEAM(4);
    if (IN(5)) {
        pg8::Gemm g{(const bf16*)(ws + WS_YN), (const bf16*)(ws + WS_WSO), TOK, 1024, 2048}; pg8::StaticOrder S; S.init(TOK, 1024, F.G, (int)blockIdx.x);
        pg8::EpiGateMul E{GATE + 1024, 2048, (const bf16*)(ws + WS_TMP), (bf16*)(ws + WS_MERGED)};
        pg8::gemm_phase<pg8::EpiGateMul, pg8::StaticOrder, true, true>(ring, g, S, E);
    }
    SEAM(5);
    if (IN(6)) {
        pg8::Gemm g{(const bf16*)(ws + WS_MERGED), (const bf16*)(ws + WS_WOUT), TOK, 1024, 1024}; pg8::StaticOrder S; S.init(TOK, 1024, F.G, (int)blockIdx.x);
        pg8::EpiResid E{p.x, (float*)(ws + WS_H2)};
        pg8::gemm_phase<pg8::EpiResid, pg8::StaticOrder, true, true>(ring, g, S, E);
    }
    SEAM(6);
    if (IN(7)) {
        const int gw = F.vcu * NWAVES + F.wave, NGW = F.G * NWAVES;
        for (int m = gw; m < TOK; m += NGW) rms_row_to_bf16((const float*)(ws + WS_H2) + (size_t)m * 1024, p.norm_ffn, (bf16*)(ws + WS_H2N) + (size_t)m * 1024, F.lane);
    }
    SEAM(7);
    if (IN(8)) {
        pg8::Gemm g{(const bf16*)(ws + WS_H2N), (const bf16*)(ws + WS_WR), TOK, 256, 1024}; pg8::StaticOrder S; S.init(TOK, 256, F.G, (int)blockIdx.x);
        pg8::EpiRouter E{p.b_rg, p.b_re, (int*)(ws + WS_ASGE), (int*)(ws + WS_ASGP), (float*)(ws + WS_ASGW), (unsigned*)(F.ctl + CW_CNT)};
        pg8::gemm_phase<pg8::EpiRouter, pg8::StaticOrder, false, true>(ring, g, S, E);
    }
    SEAM(8);
    if (IN(9)) { build_moe_tables(F); p9_gather(p, F); }
    SEAM(9);
    if (IN(10)) {
        build_moe_tables(F);
        const LAS unsigned* TBL = (const LAS unsigned*)(F.lds + TBL_OFF); const int nblk = (int)((const LAS unsigned*)(F.lds + PST_OFF))[64];
        pg8::Gemm g{(const bf16*)(ws + WS_XS), (const bf16*)(ws + WS_WGU), MAXBLK * 256, 1024, 1024}; pg8::MoeOrder S{TBL, nblk * 4, F.G, (int)blockIdx.x};
        pg8::EpiSwiGLU E{(bf16*)(ws + WS_ACT)};
        pg8::gemm_phase<pg8::EpiSwiGLU, pg8::MoeOrder, true, true>(ring, g, S, E);
    }
    SEAM(10);
    if (IN(11)) {
        build_moe_tables(F);
        const LAS unsigned* TBL = (const LAS unsigned*)(F.lds + TBL_OFF); const int nblk = (int)((const LAS unsigned*)(F.lds + PST_OFF))[64];
        pg8::Gemm g{(const bf16*)(ws + WS_ACT), (const bf16*)(ws + WS_WDN), MAXBLK * 256, 1024, 512}; pg8::MoeOrder S{TBL, nblk * 4, F.G, (int)blockIdx.x};
        pg8::EpiMoeDown E{(const int*)(ws + WS_ROWA), (const float*)(ws + WS_ROWW), (bf16*)(ws + WS_SLOT), TBL};
        pg8::gemm_phase<pg8::EpiMoeDown, pg8::MoeOrder, true, true>(ring, g, S, E);
    }
    SEAM(11);
    if (IN(12)) { p12_final(p, F); }

#ifdef DBG_DUMP
    if (IN(13)) {
        const int gw = F.vcu * NWAVES + F.wave, NGW = F.G * NWAVES;
        for (int m = gw; m < TOK; m += NGW) for (int j = F.lane; j < 1024; j += 64) {
            float v = 0.f;
            if (DBG_DUMP == 1) { v = bflo(U[(size_t)m * 1024 + j]) + bflo(Z[(size_t)m * 2048 + j]) + bflo(Z[(size_t)m * 2048 + 1024 + j]) + bflo(XBC[(size_t)m * 3072 + j]) + bflo(XBC[(size_t)m * 3072 + 1024 + j]) + bflo(XBC[(size_t)m * 3072 + 2048 + j])
                                   + bflo(GATE[(size_t)m * 2048 + j]) + bflo(GATE[(size_t)m * 2048 + 1024 + j]) + ((const float*)(ws + WS_DT))[(size_t)m * 32 + (j & 31)]; }
            if (DBG_DUMP >= 20 && DBG_DUMP < 30) { const int b = m >> 13, t = m & 8191, P = t + 128; const bf16* XST = (const bf16*)(ws + WS_XST); const bf16* BT = (const bf16*)(ws + WS_BT); const bf16* CN = (const bf16*)(ws + WS_CN); const bf16* GM = (const bf16*)(ws + WS_G);
                if (DBG_DUMP == 21) v = bflo(((const bf16*)(ws + WS_D))[(size_t)m * 1024 + j]);
                if (DBG_DUMP == 22) v = bflo(XST[((size_t)b * 2048 + j) * PADLEN + P]) + bflo(XST[((size_t)b * 2048 + 1024 + j) * PADLEN + P]);
                if (DBG_DUMP == 23) v = bflo(BT[((size_t)b * 512 + (j & 511)) * PADLEN + P]) + bflo(CN[((size_t)b * PADLEN + P) * 512 + (j & 511)]);
                if (DBG_DUMP == 24) v = ((const float*)(ws + WS_ACS))[((size_t)b * 32 + (j & 31)) * PADLEN + P] + ((const float*)(ws + WS_DTC))[((size_t)b * 32 + (j & 31)) * PADLEN + P];
                if (DBG_DUMP == 25) { const int c = (P >> 7), l = P & 127, s = j & 127, g = (j >> 7) & 3; if (s <= l) v = bflo(GM[(((size_t)(b * NCH + c) * 4 + g) * 128 + l) * 128 + s]); } }
            if (DBG_DUMP == 3) { v = bflo(((const bf16*)(ws + WS_Y))[(size_t)m * 2048 + j]) + bflo(((const bf16*)(ws + WS_Y))[(size_t)m * 2048 + 1024 + j]) + bflo(((const bf16*)(ws + WS_TMP))[(size_t)m * 1024 + j]); }
            if (DBG_DUMP == 4) { v = bflo(((const bf16*)(ws + WS_YN))[(size_t)m * 2048 + j]) + bflo(((const bf16*)(ws + WS_YN))[(size_t)m * 2048 + 1024 + j]); }
            if (DBG_DUMP == 5) { v = bflo(((const bf16*)(ws + WS_MERGED))[(size_t)m * 1024 + j]); }
            if (DBG_DUMP == 6) { v = ((const float*)(ws + WS_H2))[(size_t)m * 1024 + j]; }
            if (DBG_DUMP == 7) { v = bflo(((const bf16*)(ws + WS_H2N))[(size_t)m * 1024 + j]); }
            if (DBG_DUMP == 8) { v = (float)((const int*)(ws + WS_ASGE))[2 * m + (j & 1)] + ((const float*)(ws + WS_ASGW))[2 * m + (j & 1)]; }
            if (DBG_DUMP == 11) { v = bflo(((const bf16*)(ws + WS_SLOT))[(size_t)(2 * m) * 1024 + j]) + bflo(((const bf16*)(ws + WS_SLOT))[(size_t)(2 * m + 1) * 1024 + j]); }
            if (!(fabsf(v) < 1e30f)) v = 1e4f;
            p.out[(size_t)m * 1024 + j] = v; }
    }
#endif
#undef IN
#undef SEAM
}

extern "C" void kernel_launch(void* const* d_in, const int* in_sizes, int n_in, void* d_out, int out_size, void* d_ws, size_t ws_size, hipStream_t stream) {
    static int grid = 0;
    if (grid == 0) {
        if (n_in != 23 || in_sizes[0] != TOK * DM || out_size != TOK * DM || ws_size < WS_END) { fprintf(stderr, "kernel_launch: unexpected shapes: n_in %d in0 %d out %d ws %zu (need %zu)\n", n_in, n_in > 0 ? in_sizes[0] : -1, out_size, ws_size, (size_t)WS_END); grid = -1; return; }
        int dev = 0, cus = 0, per_cu = 0;
        if (hipGetDevice(&dev) != hipSuccess || hipDeviceGetAttribute(&cus, hipDeviceAttributeMultiprocessorCount, dev) != hipSuccess) { grid = -1; return; }
        if (hipFuncSetAttribute((const void*)mk_fwd, hipFuncAttributeMaxDynamicSharedMemorySize, LDS_BYTES) != hipSuccess) { fprintf(stderr, "kernel_launch: hipFuncSetAttribute failed\n"); grid = -1; return; }
        if (hipOccupancyMaxActiveBlocksPerMultiprocessor(&per_cu, (const void*)mk_fwd, NTHR, LDS_BYTES) != hipSuccess || per_cu < 1) { fprintf(stderr, "kernel_launch: occupancy query says %d\n", per_cu); }
        (void)hipGetLastError();
        grid = cus;
    }
    if (grid < 0) return;
    (void)hipMemsetAsync((char*)d_ws + WS_CTL, 0, CTL_ZERO_BYTES, stream);
    Params p{};
    const float** pf = (const float**)&p;
    for (int i = 0; i < 23; ++i) pf[i] = (const float*)d_in[i];
    p.out = (float*)d_out; p.ws = (unsigned char*)d_ws;
#if MK_ONE_LAUNCH
    p.ph_lo = 0; p.ph_hi = NPHASE;
    hipLaunchKernelGGL(mk_fwd, dim3(grid), dim3(NTHR), LDS_BYTES, stream, p);
#else
#ifdef DBG_DUMP
    for (int k = 0; k <= (DBG_DUMP >= 20 ? 2 : DBG_DUMP); ++k) { p.ph_lo = k; p.ph_hi = k + 1; hipLaunchKernelGGL(mk_fwd, dim3(grid), dim3(NTHR), LDS_BYTES, stream, p); }
    p.ph_lo = 13; p.ph_hi = 14; hipLaunchKernelGGL(mk_fwd, dim3(grid), dim3(NTHR), LDS_BYTES, stream, p);
#else
    for (int k = 0; k < NPHASE; ++k) { p.ph_lo = k; p.ph_hi = k + 1; hipLaunchKernelGGL(mk_fwd, dim3(grid), dim3(NTHR), LDS_BYTES, stream, p); }
#endif
#endif
}
```

```cpp
#include <hip/hip_runtime.h>
#include <cstdio>
#include <cstdint>
namespace pg8 {
#define PG8_LAS __attribute__((address_space(3)))
typedef unsigned short bf16_t;
typedef short bf16x8 __attribute__((ext_vector_type(8)));
typedef float f32x4 __attribute__((ext_vector_type(4)));
typedef unsigned u32x4 __attribute__((ext_vector_type(4)));
constexpr int BM = 256, BK = 64, HALF = 128, HTB = HALF * BK * 2  , STAGE_BYTES = 8 * HTB, NXCD = 8, WGM = 8;

__host__ __device__ __forceinline__ int lds_byte(int r, int c) { const int st = (r >> 4) * 2 + (c >> 5), rr = r & 15, cc = c & 31, ob = rr * 64 + cc * 2; return st * 1024 + (ob ^ (((ob >> 9) & 1) << 5)); }
__host__ __device__ __forceinline__ void stage_rc(int b, int& R, int& C) { const int st = b / 1024, sb = b % 1024, swz = sb ^ (((sb >> 9) & 1) << 5); R = (st >> 1) * 16 + swz / 64; C = (st & 1) * 32 + (swz % 64) / 2; }
__host__ __device__ __forceinline__ int perm32(int rho) { const int n = rho >> 4, i = rho & 15; return 8 * (i >> 2) + 4 * n + (i & 3); }

struct Unit { int pm, pn; };
struct Gemm { const bf16_t* A; const bf16_t* Bt; int M, N, K; const int* gidx; };

struct StaticOrder {
    int nM, nN, nwg, G, c;
    __host__ __device__ void init(int M, int N, int G_, int c_) { nM = M / BM; nN = N / BM; nwg = nM * nN; G = G_; c = c_; }
    __host__ __device__ bool next(int i, Unit& u) const {
        const long L = (long)i * G + c; if (L >= nwg) return false;
        int wgid = (int)L; { const int q = nwg / NXCD, r = nwg % NXCD, xcd = wgid % NXCD, off = wgid / NXCD; wgid = (xcd < r ? xcd * (q + 1) : r * (q + 1) + (xcd - r) * q) + off; }
        const int nig = WGM * nN, gid = wgid / nig, fm = gid * WGM, gsz = (nM - fm) < WGM ? (nM - fm) : WGM;
        u.pm = fm + ((wgid % nig) % gsz); u.pn = (wgid % nig) / gsz; return true;
    }
    __device__ __forceinline__ void a_ready(const Unit&) const {}
    __device__ __forceinline__ void done(const Unit&) const {}
};

typedef __bf16 bf16x2n __attribute__((ext_vector_type(2)));
__device__ __forceinline__ unsigned cvt_pk_bf16(float lo, float hi) { typedef float f32x2c __attribute__((ext_vector_type(2))); const f32x2c v = {lo, hi}; return __builtin_bit_cast(unsigned, __builtin_convertvector(v, bf16x2n)); }
typedef float f32x2 __attribute__((ext_vector_type(2)));

#define PG8_GAS __attribute__((address_space(1)))
__device__ __forceinline__ float sigmoid_f(float x) { return __builtin_amdgcn_rcpf(1.0f + __expf(-x)); }
__device__ __forceinline__ float silu_f(float x) { return x * sigmoid_f(x); }
__device__ __forceinline__ float softplus_f(float x) { return fmaxf(x, 0.f) + log1pf(__expf(-fabsf(x))); }
__device__ __forceinline__ float bf_lo(unsigned w) { return __uint_as_float(w << 16); }
__device__ __forceinline__ float bf_hi(unsigned w) { return __uint_as_float(w & 0xffff0000u); }

struct EpiProj {
    static constexpr bool PERM = true, AFTER_DRAIN = false;
    bf16_t *U, *Z, *XBC, *GATE; float* DT; const float* dt_bias;
    __device__ __forceinline__ void operator()(const f32x4 (&acc)[2][2][4][2], const Unit& u, int wr, int wc, int fr, int fq) const {
        const int row0 = u.pm * BM + wr * 64 + fr;
        if (u.pn < 32) {
            bf16_t* base; int ldc, ct; const bool sig = (u.pn >= 24);
            if (u.pn < 4) { base = U; ldc = 1024; ct = u.pn; }
            else if (u.pn < 12) { base = Z; ldc = 2048; ct = u.pn - 4; }
            else if (u.pn < 24) { base = XBC; ldc = 3072; ct = u.pn - 12; }
            else { base = GATE; ldc = 2048; ct = u.pn - 24; }
            const int col0 = ct * BM + wc * 32 + 8 * fq;
#pragma unroll
            for (int ai = 0; ai < 2; ++ai)
#pragma unroll
                for (int m = 0; m < 4; ++m) { bf16_t* rowp = base + (size_t)(row0 + ai * HALF + m * 16) * ldc + col0;
#pragma unroll
                    for (int bj = 0; bj < 2; ++bj) { f32x4 v0 = acc[ai][bj][m][0], v1 = acc[ai][bj][m][1];
                        if (sig) {
#pragma unroll
                            for (int j = 0; j < 4; ++j) { v0[j] = sigmoid_f(v0[j]); v1[j] = sigmoid_f(v1[j]); } }
                        u32x4 w; w.x = cvt_pk_bf16(v0[0], v0[1]); w.y = cvt_pk_bf16(v0[2], v0[3]); w.z = cvt_pk_bf16(v1[0], v1[1]); w.w = cvt_pk_bf16(v1[2], v1[3]);
                        *(PG8_GAS u32x4*)(rowp + bj * HALF) = w; } }
        } else if (wc == 0) {
            const f32x4 b0 = *(const f32x4*)(dt_bias + 8 * fq), b1 = *(const f32x4*)(dt_bias + 8 * fq + 4);
#pragma unroll
            for (int ai = 0; ai < 2; ++ai)
#pragma unroll
                for (int m = 0; m < 4; ++m) { float* rowp = DT + (size_t)(row0 + ai * HALF + m * 16) * 32 + 8 * fq;
                    f32x4 v0 = acc[ai][0][m][0] + b0, v1 = acc[ai][0][m][1] + b1;
#pragma unroll
                    for (int j = 0; j < 4; ++j) { v0[j] = softplus_f(v0[j]); v1[j] = softplus_f(v1[j]); }
                    *(PG8_GAS f32x4*)rowp = v0; *(PG8_GAS f32x4*)(rowp + 4) = v1; }
        }
    }
};
struct EpiGateMul {
    static constexpr bool PERM = true, AFTER_DRAIN = false;
    const bf16_t* gate; int ldg; const bf16_t* add; bf16_t* O;
    __device__ __forceinline__ void operator()(const f32x4 (&acc)[2][2][4][2], const Unit& u, int wr, int wc, int fr, int fq) const {
        const int row0 = u.pm * BM + wr * 64 + fr, col0 = u.pn * BM + wc * 32 + 8 * fq;
#pragma unroll
        for (int ai = 0; ai < 2; ++ai)
#pragma unroll
            for (int m = 0; m < 4; ++m) { const size_t r = (size_t)(row0 + ai * HALF + m * 16);
#pragma unroll
                for (int bj = 0; bj < 2; ++bj) { const int c = col0 + bj * HALF;
                    const u32x4 gw = *(const PG8_GAS u32x4*)(gate + r * ldg + c);
                    f32x4 v0 = acc[ai][bj][m][0], v1 = acc[ai][bj][m][1];
                    v0[0] *= bf_lo(gw.x); v0[1] *= bf_hi(gw.x); v0[2] *= bf_lo(gw.y); v0[3] *= bf_hi(gw.y);
                    v1[0] *= bf_lo(gw.z); v1[1] *= bf_hi(gw.z); v1[2] *= bf_lo(gw.w); v1[3] *= bf_hi(gw.w);
                    if (add) { const u32x4 aw = *(const PG8_GAS u32x4*)(add + r * 1024 + c);
                        v0[0] += bf_lo(aw.x); v0[1] += bf_hi(aw.x); v0[2] += bf_lo(aw.y); v0[3] += bf_hi(aw.y);
                        v1[0] += bf_lo(aw.z); v1[1] += bf_hi(aw.z); v1[2] += bf_lo(aw.w); v1[3] += bf_hi(aw.w); }
                    u32x4 w; w.x = cvt_pk_bf16(v0[0], v0[1]); w.y = cvt_pk_bf16(v0[2], v0[3]); w.z = cvt_pk_bf16(v1[0], v1[1]); w.w = cvt_pk_bf16(v1[2], v1[3]);
                    *(PG8_GAS u32x4*)(O + r * 1024 + c) = w; } }
    }
};
struct EpiResid {
    static constexpr bool PERM = false, AFTER_DRAIN = false;
    const float* res; float* C; bf16_t* HG; const float* gain; float* SSQ;
    __device__ __forceinline__ void operator()(const f32x4 (&acc)[2][2][4][2], const Unit& u, int wr, int wc, int fr, int fq) const {
        const int row0 = u.pm * BM + wr * 64 + fr, col0 = u.pn * BM + wc * 32 + 4 * fq;
        f32x4 gv[2][2];
#pragma unroll
        for (int bj = 0; bj < 2; ++bj)
#pragma unroll
            for (int n = 0; n < 2; ++n) gv[bj][n] = *(const PG8_GAS f32x4*)(gain + col0 + bj * HALF + n * 16);
#pragma unroll
        for (int ai = 0; ai < 2; ++ai)
#pragma unroll
            for (int m = 0; m < 4; ++m) { const int row = row0 + ai * HALF + m * 16; const size_t off = (size_t)row * 1024 + col0; float ss = 0.f;
#pragma unroll
                for (int bj = 0; bj < 2; ++bj)
#pragma unroll
                    for (int n = 0; n < 2; ++n) { const f32x4 rv = *(const PG8_GAS f32x4*)(res + off + bj * HALF + n * 16); const f32x4 v = acc[ai][bj][m][n] + rv;
                        *(PG8_GAS f32x4*)(C + off + bj * HALF + n * 16) = v; ss += (v[0] * v[0] + v[1] * v[1]) + (v[2] * v[2] + v[3] * v[3]);
                        const f32x4 hg = v * gv[bj][n]; typedef unsigned u32x2e __attribute__((ext_vector_type(2))); u32x2e o; o.x = cvt_pk_bf16(hg[0], hg[1]); o.y = cvt_pk_bf16(hg[2], hg[3]);
                        *(PG8_GAS u32x2e*)(HG + off + bj * HALF + n * 16) = o; }
                ss += __shfl_xor(ss, 16); ss += __shfl_xor(ss, 32);
                if (fq == 0) SSQ[(size_t)row * 16 + u.pn * 4 + wc] = ss; }
    }
};
struct EpiSwiGLU {
    static constexpr bool PERM = true, AFTER_DRAIN = false;
    bf16_t* ACT; const float* row_rs;
    __device__ __forceinline__ void operator()(const f32x4 (&acc)[2][2][4][2], const Unit& u, int wr, int wc, int fr, int fq) const {
        const int row0 = u.pm * BM + wr * 64 + fr, col0 = (u.pn & 3) * HALF + wc * 32 + 8 * fq;
#pragma unroll
        for (int ai = 0; ai < 2; ++ai)
#pragma unroll
            for (int m = 0; m < 4; ++m) { f32x4 v0, v1; const float rs = row_rs[row0 + ai * HALF + m * 16];
#pragma unroll
                for (int j = 0; j < 4; ++j) { v0[j] = silu_f(acc[ai][0][m][0][j] * rs) * (acc[ai][1][m][0][j] * rs); v1[j] = silu_f(acc[ai][0][m][1][j] * rs) * (acc[ai][1][m][1][j] * rs); }
                u32x4 w; w.x = cvt_pk_bf16(v0[0], v0[1]); w.y = cvt_pk_bf16(v0[2], v0[3]); w.z = cvt_pk_bf16(v1[0], v1[1]); w.w = cvt_pk_bf16(v1[2], v1[3]);
                *(PG8_GAS u32x4*)(ACT + (size_t)(row0 + ai * HALF + m * 16) * 512 + col0) = w; }
    }
};
struct EpiMoeDown {
    static constexpr bool PERM = true, AFTER_DRAIN = false;
    const int* row_a; const float* row_w; bf16_t* SLOT; const PG8_LAS unsigned* tbl;
    __device__ __forceinline__ void operator()(const f32x4 (&acc)[2][2][4][2], const Unit& u, int wr, int wc, int fr, int fq) const {
        const int nvalid = (int)(tbl[u.pm] >> 8);
        const int lr0 = wr * 64 + fr, col0 = (u.pn & 3) * BM + wc * 32 + 8 * fq;
#pragma unroll
        for (int ai = 0; ai < 2; ++ai)
#pragma unroll
            for (int m = 0; m < 4; ++m) { const int lr = lr0 + ai * HALF + m * 16;
                if (lr < nvalid) { const int gr = u.pm * BM + lr; const int a = row_a[gr]; const float w = row_w[gr];
#pragma unroll
                    for (int bj = 0; bj < 2; ++bj) { const f32x4 v0 = acc[ai][bj][m][0] * w, v1 = acc[ai][bj][m][1] * w;
                        u32x4 o; o.x = cvt_pk_bf16(v0[0], v0[1]); o.y = cvt_pk_bf16(v0[2], v0[3]); o.z = cvt_pk_bf16(v1[0], v1[1]); o.w = cvt_pk_bf16(v1[2], v1[3]);
                        *(PG8_GAS u32x4*)(SLOT + (size_t)a * 1024 + col0 + bj * HALF) = o; } } }
    }
};
struct EpiRouter {
    static constexpr bool PERM = false, AFTER_DRAIN = true;
    const float *b_rg, *b_re; int* asg_e; int* asg_pos; float* asg_w; unsigned* cnt; const float* SSQ;
    __device__ __forceinline__ void fused(f32x4 (&acc)[2][2][4][2], const Unit& u, int wr, int wc, int fr, int fq, PG8_LAS unsigned char* lds, int wid, int lane) const {
        PG8_LAS float* L = (PG8_LAS float*)lds;
        if (wc < 3) {
#pragma unroll
            for (int ai = 0; ai < 2; ++ai)
#pragma unroll
                for (int m = 0; m < 4; ++m) { const int r = ai * HALF + wr * 64 + m * 16 + fr;
#pragma unroll
                    for (int n = 0; n < 2; ++n) { const int c = wc * 32 + n * 16 + 4 * fq;
                        if (c < 72) {
#pragma unroll
                            for (int j = 0; j < 4; ++j) L[r * 73 + c + j] = acc[ai][0][m][n][j]; } } }
        }
        asm volatile("s_waitcnt lgkmcnt(0)" ::: "memory"); __builtin_amdgcn_s_barrier(); asm volatile("" ::: "memory");
        const int tid = wid * 64 + lane;
        if (tid < 256) {
            const PG8_LAS float* lr = L + tid * 73; const int tok = u.pm * BM + tid;
            float rs; { const f32x4 q0 = *(const PG8_GAS f32x4*)(SSQ + (size_t)tok * 16), q1 = *(const PG8_GAS f32x4*)(SSQ + (size_t)tok * 16 + 4), q2 = *(const PG8_GAS f32x4*)(SSQ + (size_t)tok * 16 + 8), q3 = *(const PG8_GAS f32x4*)(SSQ + (size_t)tok * 16 + 12);
                const f32x4 q = (q0 + q1) + (q2 + q3); rs = 1.0f / sqrtf(((q[0] + q[1]) + (q[2] + q[3])) * (1.f / 1024.f) + 1e-6f); }
            float gl[8]; float gm = -3.0e38f; int gi = 0;
#pragma unroll
            for (int j = 0; j < 8; ++j) { gl[j] = lr[j] * rs + b_rg[j]; if (gl[j] > gm) { gm = gl[j]; gi = j; } }
            float gs = 0.f;
#pragma unroll
            for (int j = 0; j < 8; ++j) gs += __expf(gl[j] - gm);
            const float g_p = 1.0f / gs;
            float e1 = -3.0e38f, e2 = -3.0e38f; int i1 = 0, i2 = 0;
#pragma unroll
            for (int j = 0; j < 8; ++j) { const float v = lr[8 + gi * 8 + j] * rs + b_re[gi * 8 + j];
                if (v > e1) { e2 = e1; i2 = i1; e1 = v; i1 = j; } else if (v > e2) { e2 = v; i2 = j; } }
            const float t = __expf(e2 - e1), w1 = 1.0f / (1.0f + t), w2 = t * w1;
            const int x1 = gi * 8 + i1, x2 = gi * 8 + i2;
            const int p1 = (int)__hip_atomic_fetch_add(cnt + x1, 1u, __ATOMIC_RELAXED, __HIP_MEMORY_SCOPE_AGENT);
            const int p2 = (int)__hip_atomic_fetch_add(cnt + x2, 1u, __ATOMIC_RELAXED, __HIP_MEMORY_SCOPE_AGENT);
            asg_e[2 * tok] = x1; asg_pos[2 * tok] = p1; asg_w[2 * tok] = g_p * w1;
            asg_e[2 * tok + 1] = x2; asg_pos[2 * tok + 1] = p2; asg_w[2 * tok + 1] = g_p * w2;
        }
    }
};
struct MoeOrder {
    const PG8_LAS unsigned* tbl; int nunits, G, c;
    __device__ __forceinline__ bool next(int i, Unit& u) const {
        const int L = i * G + c; if (L >= nunits) return false;
        const int blk = L >> 2; const int e = (int)(__builtin_amdgcn_readfirstlane(tbl[blk]) & 0xffu);
        u.pm = blk; u.pn = e * 4 + (L & 3); return true;
    }
    __device__ __forceinline__ void a_ready(const Unit&) const {}
    __device__ __forceinline__ void done(const Unit&) const {}
};
template <class Epi, class Sched, bool ALIGN_EPI = false, bool SP2 = false, bool GATHER = false>
__device__ __forceinline__ void gemm_phase(PG8_LAS unsigned char* lds, const Gemm g, const Sched& S, const Epi& E) {
    const int tid = threadIdx.x, wid = __builtin_amdgcn_readfirstlane(tid >> 6), lane = tid & 63, wr = wid >> 2, wc = wid & 3, fr = lane & 15, fq = lane >> 4;
    const int K = g.K, nt = K / BK;
    unsigned voffA[2], voffB[2]; int sR[2]; unsigned sC2[2];
#pragma unroll
    for (int i = 0; i < 2; ++i) { int R, C; stage_rc(tid * 16 + i * 8192, R, C); const int Rb = Epi::PERM ? ((R & ~31) + perm32(R & 31)) : R;
        voffA[i] = (unsigned)(R * K + C) * 2u; voffB[i] = (unsigned)(Rb * K + C) * 2u; sR[i] = R; sC2[i] = (unsigned)C * 2u; }
    static_assert(!GATHER || SP2, "GATHER is implemented for the SP2 loop");
    unsigned vgC[2][2] = {{0u, 0u}, {0u, 0u}}, vgN[2][2] = {{0u, 0u}, {0u, 0u}};
#define PG8_GIDX(dst, u_) do { _Pragma("unroll") for (int _h = 0; _h < 2; ++_h) _Pragma("unroll") for (int _i = 0; _i < 2; ++_i) \
        dst[_h][_i] = (unsigned)g.gidx[(u_).pm * BM + _h * HALF + sR[_i]] * (unsigned)(K * 2) + sC2[_i]; } while (0)
#define PG8_STGA_CUR(bufoff, gbase, hh) do { if constexpr (GATHER) { PG8_STAGE(bufoff, gbase, vgC[hh]); } else { PG8_STAGE(bufoff, (gbase) + (hh) * hstep, voffA); } } while (0)
#define PG8_STGA_NXT(bufoff, gbase, hh) do { if constexpr (GATHER) { const unsigned _vs[2] = {last ? vgN[hh][0] * (unsigned)(K * 2) + sC2[0] : vgC[hh][0], last ? vgN[hh][1] * (unsigned)(K * 2) + sC2[1] : vgC[hh][1]}; PG8_STAGE(bufoff, gbase, _vs); } else { PG8_STAGE(bufoff, (gbase) + (hh) * hstep, voffA); } } while (0)
#define PG8_GIDX_RAW(dst, u_) do { _Pragma("unroll") for (int _h = 0; _h < 2; ++_h) _Pragma("unroll") for (int _i = 0; _i < 2; ++_i) dst[_h][_i] = (unsigned)g.gidx[(u_).pm * BM + _h * HALF + sR[_i]]; } while (0)
    const size_t kstep = (size_t)(BK * 2);
    const size_t hstep = (size_t)HALF * K * 2;
    const size_t tstep = 2 * hstep;
    const unsigned ldsw = (unsigned)wid * 1024u;
    const int aoff = lds_byte(wr * 64 + fr, fq * 8), boff = lds_byte(wc * 32 + fr, fq * 8);
#define PG8_SA(b, h) (((b) * 2 + (h)) * HTB)
#define PG8_SB(b, h) ((4 + (b) * 2 + (h)) * HTB)
#define PG8_STAGE(bufoff, gbase, voff) do { _Pragma("unroll") for (int _i = 0; _i < 2; ++_i) \
        __builtin_amdgcn_global_load_lds((const unsigned*)((const char*)(gbase) + (voff)[_i]), (PG8_LAS unsigned*)(lds + (bufoff) + ldsw + _i * 8192), 16, 0, 0); } while (0)
#define PG8_LDA(dst, b, h) do { _Pragma("unroll") for (int m = 0; m < 4; ++m) _Pragma("unroll") for (int k = 0; k < 2; ++k) dst[m][k] = *(const PG8_LAS bf16x8*)(lds + PG8_SA(b, h) + aoff + m * 2048 + k * 1024); } while (0)
#define PG8_LDB(dst, b, h) do { _Pragma("unroll") for (int n = 0; n < 2; ++n) _Pragma("unroll") for (int k = 0; k < 2; ++k) dst[n][k] = *(const PG8_LAS bf16x8*)(lds + PG8_SB(b, h) + boff + n * 2048 + k * 1024); } while (0)
#define PG8_MMA(ai, bj, At, Bt) do { __builtin_amdgcn_s_setprio(1); _Pragma("unroll") for (int m = 0; m < 4; ++m) _Pragma("unroll") for (int n = 0; n < 2; ++n) _Pragma("unroll") for (int k = 0; k < 2; ++k) \
        acc[ai][bj][m][n] = __builtin_amdgcn_mfma_f32_16x16x32_bf16(Bt[n][k], At[m][k], acc[ai][bj][m][n], 0, 0, 0); __builtin_amdgcn_s_setprio(0); } while (0)
#define PG8_WAIT_V(n) asm volatile("s_waitcnt vmcnt(" #n ")" ::: "memory")
#define PG8_WAIT_L(n) asm volatile("s_waitcnt lgkmcnt(" #n ")" ::: "memory")
#define PG8_BAR __builtin_amdgcn_s_barrier()
#define PG8_SCHED __builtin_amdgcn_sched_barrier(0)
    Unit cur, nxt; int ui = 0;
    if (!S.next(0, cur)) return;
    f32x4 acc[2][2][4][2];
#pragma unroll
    for (int a = 0; a < 2; ++a)
#pragma unroll
        for (int b = 0; b < 2; ++b)
#pragma unroll
            for (int m = 0; m < 4; ++m)
#pragma unroll
                for (int n = 0; n < 2; ++n) acc[a][b][m][n] = (f32x4){0.f, 0.f, 0.f, 0.f};
    bf16x8 At[4][2], B0[2][2], B1[2][2];
    const char* cA = GATHER ? (const char*)g.A : (const char*)g.A + (size_t)cur.pm * tstep; const char* cB = (const char*)g.Bt + (size_t)cur.pn * tstep;
    if constexpr (GATHER) { PG8_GIDX(vgC, cur); }
    S.a_ready(cur);
    if constexpr (SP2) {
        PG8_STAGE(PG8_SB(0, 0), cB, voffB); PG8_STAGE(PG8_SB(0, 1), cB + hstep, voffB); PG8_STGA_CUR(PG8_SA(0, 0), cA, 0); PG8_STGA_CUR(PG8_SA(0, 1), cA, 1);
        if (wr == 1) PG8_BAR;
        PG8_WAIT_V(2); PG8_BAR;
        PG8_STAGE(PG8_SB(1, 0), cB + kstep, voffB); PG8_STGA_CUR(PG8_SA(1, 0), cA + kstep, 0); PG8_STAGE(PG8_SB(1, 1), cB + hstep + kstep, voffB);
        PG8_WAIT_V(6); PG8_BAR;
    } else {
        PG8_STAGE(PG8_SB(0, 0), cB, voffB); PG8_STAGE(PG8_SA(0, 0), cA, voffA); PG8_STAGE(PG8_SB(0, 1), cB + hstep, voffB); PG8_STAGE(PG8_SA(0, 1), cA + hstep, voffA);
        if (wr == 1) PG8_BAR;
        PG8_WAIT_V(4); PG8_BAR;
        PG8_STAGE(PG8_SB(1, 0), cB + kstep, voffB); PG8_STAGE(PG8_SA(1, 0), cA + kstep, voffA); PG8_STAGE(PG8_SB(1, 1), cB + hstep + kstep, voffB);
        PG8_WAIT_V(6); PG8_BAR;
    }
    for (;;) {
        const bool has_next = S.next(ui + 1, nxt);
        if constexpr (GATHER) { if (has_next) { PG8_GIDX_RAW(vgN, nxt); } else { PG8_GIDX_RAW(vgN, cur); } }
        const char* nA = GATHER ? cA : (has_next ? (const char*)g.A + (size_t)nxt.pm * tstep : cA); const char* nB = has_next ? (const char*)g.Bt + (size_t)nxt.pn * tstep : cB;
        for (int t = 0; t < nt; t += 2) {
            const bool last = (t == nt - 2);
            const char* a1 = cA + (size_t)(t + 1) * kstep;
            const char* a2 = last ? nA : cA + (size_t)(t + 2) * kstep; const char* b2 = last ? nB : cB + (size_t)(t + 2) * kstep;
            const char* a3 = a2 + kstep; const char* b3 = b2 + kstep;
            if (last && has_next) S.a_ready(nxt);
            if constexpr (SP2) {
            PG8_LDB(B0, 0, 0); PG8_LDB(B1, 0, 1); PG8_SCHED; PG8_LDA(At, 0, 0); PG8_STGA_CUR(PG8_SA(1, 1), a1, 1);
            PG8_WAIT_V(8); PG8_WAIT_L(0); PG8_BAR; PG8_MMA(0, 0, At, B0); PG8_MMA(0, 1, At, B1); PG8_BAR; PG8_SCHED;
            PG8_LDA(At, 0, 1); PG8_STAGE(PG8_SB(0, 0), b2, voffB); PG8_STAGE(PG8_SB(0, 1), b2 + hstep, voffB); PG8_STGA_NXT(PG8_SA(0, 0), a2, 0);
            PG8_WAIT_V(8); PG8_WAIT_L(0); PG8_BAR; PG8_MMA(1, 0, At, B0); PG8_MMA(1, 1, At, B1); PG8_BAR; PG8_SCHED;
            PG8_LDB(B0, 1, 0); PG8_LDB(B1, 1, 1); PG8_SCHED; PG8_LDA(At, 1, 0); PG8_STGA_NXT(PG8_SA(0, 1), a2, 1);
            PG8_WAIT_V(8); PG8_WAIT_L(0); PG8_BAR; PG8_MMA(0, 0, At, B0); PG8_MMA(0, 1, At, B1); PG8_BAR; PG8_SCHED;
            PG8_LDA(At, 1, 1); PG8_STAGE(PG8_SB(1, 0), b3, voffB); PG8_STAGE(PG8_SB(1, 1), b3 + hstep, voffB); PG8_STGA_NXT(PG8_SA(1, 0), a3, 0);
            PG8_WAIT_V(8); PG8_WAIT_L(0); PG8_BAR; PG8_MMA(1, 0, At, B0); PG8_MMA(1, 1, At, B1); PG8_BAR; PG8_SCHED;
            } else {
            PG8_LDB(B0, 0, 0); PG8_SCHED; PG8_LDA(At, 0, 0); PG8_STAGE(PG8_SA(1, 1), a1 + hstep, voffA);
            PG8_WAIT_L(8); PG8_BAR; PG8_WAIT_L(0); PG8_MMA(0, 0, At, B0); PG8_BAR; PG8_SCHED;
            PG8_LDB(B1, 0, 1); PG8_STAGE(PG8_SB(0, 0), b2, voffB);
            PG8_BAR; PG8_WAIT_L(0); PG8_MMA(0, 1, At, B1); PG8_BAR;
            PG8_LDA(At, 0, 1); PG8_STAGE(PG8_SA(0, 0), a2, voffA);
            PG8_BAR; PG8_WAIT_L(0); PG8_MMA(1, 0, At, B0); PG8_BAR; PG8_SCHED;
            PG8_STAGE(PG8_SB(0, 1), b2 + hstep, voffB);
            PG8_WAIT_V(6); PG8_BAR; PG8_MMA(1, 1, At, B1); PG8_BAR;
            PG8_LDB(B0, 1, 0); PG8_SCHED; PG8_LDA(At, 1, 0); PG8_STAGE(PG8_SA(0, 1), a2 + hstep, voffA);
            PG8_WAIT_L(8); PG8_BAR; PG8_WAIT_L(0); PG8_MMA(0, 0, At, B0); PG8_BAR; PG8_SCHED;
            PG8_LDB(B1, 1, 1); PG8_STAGE(PG8_SB(1, 0), b3, voffB);
            PG8_BAR; PG8_WAIT_L(0); PG8_MMA(0, 1, At, B1); PG8_BAR;
            PG8_LDA(At, 1, 1); PG8_STAGE(PG8_SA(1, 0), a3, voffA);
            PG8_BAR; PG8_WAIT_L(0); PG8_MMA(1, 0, At, B0); PG8_BAR; PG8_SCHED;
            PG8_STAGE(PG8_SB(1, 1), b3 + hstep, voffB);
            PG8_WAIT_V(6); PG8_BAR; PG8_MMA(1, 1, At, B1); PG8_BAR;
            }
        }
        if constexpr (ALIGN_EPI) { if (wr == 0) PG8_BAR; }
        if constexpr (!Epi::AFTER_DRAIN) { E(acc, cur, wr, wc, fr, fq); S.done(cur); }
        if (!has_next) break;
#pragma unroll
        for (int a = 0; a < 2; ++a)
#pragma unroll
            for (int b = 0; b < 2; ++b)
#pragma unroll
                for (int m = 0; m < 4; ++m)
#pragma unroll
                    for (int n = 0; n < 2; ++n) acc[a][b][m][n] = (f32x4){0.f, 0.f, 0.f, 0.f};
        cur = nxt; cA = nA; cB = nB; ++ui;
        if constexpr (GATHER) { _Pragma("unroll") for (int _h = 0; _h < 2; ++_h) _Pragma("unroll") for (int _i = 0; _i < 2; ++_i) vgC[_h][_i] = vgN[_h][_i] * (unsigned)(K * 2) + sC2[_i]; }
        if constexpr (ALIGN_EPI) { if (wr == 1) PG8_BAR; }
    }
    PG8_WAIT_V(0);
    if constexpr (!ALIGN_EPI) { if (wr == 0) PG8_BAR; }
    PG8_BAR;
    if constexpr (Epi::AFTER_DRAIN) { E.fused(acc, cur, wr, wc, fr, fq, lds, wid, lane); S.done(cur); }
#undef PG8_GIDX
#undef PG8_GIDX_RAW
#undef PG8_STGA_CUR
#undef PG8_STGA_NXT
#undef PG8_SA
#undef PG8_SB
#undef PG8_STAGE
#undef PG8_LDA
#undef PG8_LDB
#undef PG8_MMA
#undef PG8_WAIT_V
#undef PG8_WAIT_L
#undef PG8_BAR
#undef PG8_SCHED
}
}

constexpr int NWAVES = 8, NTHR = 512;
#ifndef MK_ONE_LAUNCH
#define MK_ONE_LAUNCH 1
#endif
constexpr int NPHASE = 13;

constexpr int BATCH = 4, SEQ = 8192, DM = 1024, NMETA = 16;
constexpr int TOK = BATCH * SEQ;
constexpr int METAROW = TOK;
constexpr int MROWS = TOK + 256;
constexpr int DIN = 8224, NPROJ = 8448;
constexpr int SSD_INNER = 2048, HEADS = 32, HD = 64, GROUPS = 4, HPG = 8, NSTATE = 128, CHUNK = 128, CONVD = 3072;
constexpr int NCH = 65, PADLEN = NCH * CHUNK;
constexpr int NEXP = 64, DEXP = 512, MAXBLK = 320;
constexpr float EPS = 1e-6f;

constexpr size_t MiB = 1ull << 20;
constexpr size_t WS_CTL = 0, CTL_ZERO_BYTES = 1 * MiB;
constexpr size_t WS_ASGE = 1 * MiB, WS_ASGP = WS_ASGE + 262144, WS_ASGW = WS_ASGP + 262144, WS_ROWA = WS_ASGW + 262144, WS_ROWW = WS_ROWA + 327680, WS_ROWT = WS_ROWW + 327680, WS_ROWR = WS_ROWT + 327680;
constexpr size_t WS_SSQ = 4 * MiB;
constexpr size_t WS_WIN = 8 * MiB, WS_WPE = 25 * MiB, WS_WSO = 27 * MiB, WS_WOUT = 31 * MiB, WS_WR = 33 * MiB;
constexpr size_t WS_DT = 34 * MiB, WS_ACS = 39 * MiB, WS_DTC = 44 * MiB;
constexpr size_t WS_XN = 50 * MiB, WS_U = 115 * MiB, WS_Z = 180 * MiB, WS_XBC = 309 * MiB, WS_GATE = 503 * MiB, WS_D = 632 * MiB;
constexpr size_t WS_XST = 696 * MiB, WS_BT = 826 * MiB, WS_CN = 859 * MiB, WS_G = 892 * MiB;
constexpr size_t WS_Y = 50 * MiB, WS_YN = 309 * MiB, WS_TMP = 437 * MiB, WS_WGU = 696 * MiB, WS_WDN = 824 * MiB, WS_MERGED = 926 * MiB;
constexpr size_t WS_H2 = 180 * MiB, WS_H2N = 50 * MiB, WS_XS = 309 * MiB, WS_ACT = 503 * MiB, WS_SLOT = 50 * MiB;
constexpr size_t WS_END = 990 * MiB;
static_assert(WS_ROWR + 327680 <= WS_SSQ && WS_SSQ + (size_t)TOK * 16 * 4 <= WS_WIN && WS_WIN + (size_t)NPROJ * 1024 * 2 <= WS_WPE && WS_DT + (size_t)MROWS * 32 * 4 <= WS_ACS && WS_ACS + (size_t)BATCH * HEADS * PADLEN * 4 <= WS_DTC && WS_DTC + (size_t)BATCH * HEADS * PADLEN * 4 <= WS_XN, "map 1");
static_assert(WS_XN + (size_t)MROWS * 1024 * 2 <= WS_U && WS_U + (size_t)MROWS * 1024 * 2 <= WS_Z && WS_Z + (size_t)MROWS * 2048 * 2 <= WS_XBC && WS_XBC + (size_t)MROWS * 3072 * 2 <= WS_GATE && WS_GATE + (size_t)MROWS * 2048 * 2 <= WS_D && WS_D + (size_t)TOK * 1024 * 2 <= WS_XST, "map 2");
static_assert(WS_XST + (size_t)BATCH * HEADS * HD * PADLEN * 2 <= WS_BT && WS_BT + (size_t)BATCH * GROUPS * NSTATE * PADLEN * 2 <= WS_CN && WS_CN + (size_t)BATCH * PADLEN * 512 * 2 <= WS_G && WS_G + (size_t)BATCH * NCH * GROUPS * 128 * 128 * 2 <= WS_MERGED, "map 3");
static_assert(WS_Y + (size_t)TOK * 2048 * 2 <= WS_Z && WS_YN + (size_t)TOK * 2048 * 2 <= WS_TMP && WS_TMP + (size_t)TOK * 1024 * 2 <= WS_GATE && WS_WGU + (size_t)NEXP * 1024 * 1024 * 2 <= WS_WDN && WS_WDN + (size_t)NEXP * 1024 * 512 * 2 <= WS_G, "map 4");
static_assert(WS_H2 + (size_t)TOK * 1024 * 4 <= WS_XBC && WS_XS + (size_t)MAXBLK * 256 * 1024 * 2 <= WS_GATE && WS_ACT + (size_t)MAXBLK * 256 * 512 * 2 <= WS_D && WS_SLOT + (size_t)2 * TOK * 1024 * 2 <= WS_Z && WS_MERGED + (size_t)TOK * 1024 * 2 <= WS_END, "map 5");
constexpr int CW_TMO = 0, CW_CODE = 1, CW_BAR = 4096, CW_CNT = 8192;

constexpr int RING_BYTES = 131072;
constexpr int P4_BYTES = 151552;
constexpr int LDSCTL_OFF = P4_BYTES;
constexpr int MISC_OFF = LDSCTL_OFF + 320;
constexpr int TBL_OFF = LDSCTL_OFF + 1024;
constexpr int PST_OFF = TBL_OFF + 1536;
constexpr int LDS_BYTES = 155648;
static_assert(PST_OFF + 272 <= LDS_BYTES, "LDS map");

#define GAS __attribute__((address_space(1)))
#define LAS __attribute__((address_space(3)))
typedef unsigned short bf16;
typedef unsigned v4u __attribute__((ext_vector_type(4)));
typedef unsigned v2u __attribute__((ext_vector_type(2)));
typedef float f32x4 __attribute__((ext_vector_type(4)));
typedef short bf16x8 __attribute__((ext_vector_type(8)));
typedef GAS unsigned gu32;
#define RLX_AGENT __ATOMIC_RELAXED, __HIP_MEMORY_SCOPE_AGENT
#define LDS_WAIT() asm volatile("s_waitcnt lgkmcnt(0)" ::: "memory")
#define VM_WAIT() asm volatile("s_waitcnt vmcnt(0)" ::: "memory")
__device__ __forceinline__ unsigned f2bf(float f) { unsigned u = __builtin_bit_cast(unsigned, f); return (u + 0x7fffu + ((u >> 16) & 1u)) >> 16; }
__device__ __forceinline__ unsigned pk2(float lo, float hi) { return pg8::cvt_pk_bf16(lo, hi); }
__device__ __forceinline__ float bflo(unsigned w) { return __uint_as_float(w << 16); }
__device__ __forceinline__ float bfhi(unsigned w) { return __uint_as_float(w & 0xffff0000u); }
__device__ __forceinline__ float wave_sum(float v) {
#pragma unroll
    for (int o = 1; o < 64; o <<= 1) v += __shfl_xor(v, o);
    return v;
}

#define XB_TMO      128
#define XB_XCNT(j)  (256  + 64 * (j))
#define XB_XSUB(j)  (1280 + 64 * (j))
#define XB_XGEN(j)  (2304 + 64 * (j))
#define XB_TOP      3328
#define XB_TOPGEN   3392
#define XCD_BAR_WORDS 3456
#define XB_SPIN_CAP (1u << 18)

__device__ __forceinline__ unsigned xb_ld(unsigned* p)              { return __hip_atomic_load(p, __ATOMIC_RELAXED, __HIP_MEMORY_SCOPE_AGENT); }
__device__ __forceinline__ unsigned xb_add(unsigned* p, unsigned v) { return __hip_atomic_fetch_add(p, v, __ATOMIC_RELAXED, __HIP_MEMORY_SCOPE_AGENT); }
__device__ __forceinline__ unsigned xb_xcc_id() { return (unsigned)__builtin_amdgcn_s_getreg((3 << 11) | 20) & 0xFu; }
#define XB_SPIN(cond, bar) do { unsigned _sp = 0; while (cond) { __builtin_amdgcn_s_sleep(1); \
    if ((++_sp & 255u) == 0u) { if (xb_ld(&(bar)[XB_TMO])) break; if (_sp > XB_SPIN_CAP) { atomicAdd(&(bar)[XB_TMO], 1u); break; } } } } while (0)

struct XcdBarrier {
    unsigned* bar; unsigned x;
    volatile LAS unsigned* st;
};

__device__ __forceinline__ XcdBarrier xcd_barrier_post(unsigned* bar, volatile LAS unsigned* st) {
    XcdBarrier b; b.bar = bar; b.x = xb_xcc_id(); b.st = st;
    if (threadIdx.x == 0) (void)xb_add(&bar[XB_XCNT(b.x)], 1u);
    return b;
}
__device__ __forceinline__ void xcd_barrier_complete(unsigned* bar, unsigned x, unsigned& nloc, unsigned& nx) {
    const unsigned G = gridDim.x * gridDim.y * gridDim.z;
    unsigned sum, cnt, mine, sp = 0u;
    for (;;) {
        sum = 0u; cnt = 0u; mine = 0u;
#pragma unroll
        for (unsigned j = 0; j < 16; ++j) { const unsigned c = xb_ld(&bar[XB_XCNT(j)]); sum += c; cnt += (c > 0u) ? 1u : 0u; mine = (j == x) ? c : mine; }
        if (sum == G) break;
        __builtin_amdgcn_s_sleep(1);
        if ((++sp & 255u) == 0u) { if (xb_ld(&bar[XB_TMO])) break; if (sp > XB_SPIN_CAP) { atomicAdd(&bar[XB_TMO], 1u); break; } }
    }
    nloc = mine > 0u ? mine : 1u; nx = cnt > 0u ? cnt : 1u;
}

__device__ __forceinline__ void xcd_barrier(const XcdBarrier& b) {
    asm volatile("s_waitcnt vmcnt(0)" ::: "memory");
    __syncthreads();
    if (threadIdx.x == 0) {
        unsigned* bar = b.bar;
        __builtin_amdgcn_s_waitcnt(0);
        unsigned nloc = b.st[0], nx = b.st[1];
        if (nloc == 0u) { xcd_barrier_complete(bar, b.x, nloc, nx); b.st[0] = nloc; b.st[1] = nx; }
        const unsigned old = xb_add(&bar[XB_XSUB(b.x)], 1u);
        const unsigned gen = old / nloc;
        if (old + 1u == (gen + 1u) * nloc) {
            __builtin_amdgcn_fence(__ATOMIC_RELEASE, "agent");
            asm volatile("s_waitcnt vmcnt(0)" ::: "memory");
            const unsigned og = xb_add(&bar[XB_TOP], 1u);
            const unsigned tg = og / nx;
            if (og + 1u == (tg + 1u) * nx) xb_add(&bar[XB_TOPGEN], 1u);
            else XB_SPIN(xb_ld(&bar[XB_TOPGEN]) == tg, bar);
            __builtin_amdgcn_fence(__ATOMIC_ACQUIRE, "agent");
            xb_add(&bar[XB_XGEN(b.x)], 1u);
            asm volatile("s_waitcnt vmcnt(0)" ::: "memory");
        } else {
            XB_SPIN(xb_ld(&bar[XB_XGEN(b.x)]) == gen, bar);
            __builtin_amdgcn_fence(__ATOMIC_ACQUIRE, "agent");
            asm volatile("s_waitcnt vmcnt(0)" ::: "memory");
        }
    }
    __syncthreads();
}


struct Params {
    const float *x, *meta, *norm_mix, *w_in, *pool_w, *pool_scale, *conv_w, *conv_b, *dt_bias, *a_log, *d_skip, *ssd_norm, *w_pool_out, *w_ssd_out, *w_out, *norm_ffn,
                *w_rg, *b_rg, *w_re, *b_re, *w_gu, *w_dn, *norm_final;
    float* out; unsigned char* ws; int ph_lo, ph_hi;
};

struct Frame {
    LAS unsigned char* lds; volatile LAS unsigned* MISC; gu32* ctl;
    int tid, lane, wave, vcu, G;
};

__device__ __forceinline__ int seq_row(int b, int s) { return s < NMETA ? METAROW + s : b * SEQ + s - NMETA; }

__device__ __forceinline__ void transpose_item(const float* src, int ldw, bf16* dst, int ldk, LAS float* scr, int lane) {
#pragma unroll 8
    for (int i = 0; i < 32; ++i) { const int kk = 2 * i + (lane >> 5); scr[kk * 33 + (lane & 31)] = src[(size_t)kk * ldw + (lane & 31)]; }
    LDS_WAIT(); asm volatile("" ::: "memory");
    const int c = lane & 7;
#pragma unroll
    for (int j = 0; j < 4; ++j) { const int n = (lane >> 3) + 8 * j; const LAS float* s = scr + (8 * c) * 33 + n;
        v4u o; o.x = pk2(s[0 * 33], s[1 * 33]); o.y = pk2(s[2 * 33], s[3 * 33]); o.z = pk2(s[4 * 33], s[5 * 33]); o.w = pk2(s[6 * 33], s[7 * 33]);
        *(GAS v4u*)(dst + (size_t)n * ldk + 8 * c) = o; }
    LDS_WAIT(); asm volatile("" ::: "memory");
}
__device__ __forceinline__ void rms_row_to_bf16(const float* xrow, const float* gain, bf16* orow, int lane) {
    const GAS f32x4* xr = (const GAS f32x4*)xrow + lane; const GAS f32x4* gr = (const GAS f32x4*)gain + lane;
    f32x4 v[4]; float s = 0.f;
#pragma unroll
    for (int j = 0; j < 4; ++j) { v[j] = xr[64 * j]; s += (v[j].x * v[j].x + v[j].y * v[j].y) + (v[j].z * v[j].z + v[j].w * v[j].w); }
    const float rstd = 1.0f / sqrtf(wave_sum(s) * (1.f / 1024.f) + EPS);
    GAS v2u* o8 = (GAS v2u*)orow + lane;
#pragma unroll
    for (int j = 0; j < 4; ++j) { const f32x4 g = gr[64 * j]; v2u o; o.x = pk2(v[j].x * rstd * g.x, v[j].y * rstd * g.y); o.y = pk2(v[j].z * rstd * g.z, v[j].w * rstd * g.w); o8[64 * j] = o; }
}
__device__ __forceinline__ void moe_weight_items(const Params& p, Frame& F, LAS float* scr, int first, int stride) {
    constexpr int I_GU = NEXP * 16 * 32, I_DN = NEXP * 8 * 32;
    bf16* WGU = (bf16*)(p.ws + WS_WGU); bf16* WDN = (bf16*)(p.ws + WS_WDN);
    for (int it = first; it < I_GU + I_DN; it += stride) {
        if (it < I_GU) { const int e = it >> 9, r = it & 511, kb = r >> 5, nb = r & 31, n0 = nb * 32, k0 = kb * 64;
            const int drow = ((n0 & 511) >> 7) * 256 + (n0 >= 512 ? 128 : 0) + (n0 & 127);
            transpose_item(p.w_gu + (size_t)e * 1024 * 1024 + (size_t)k0 * 1024 + n0, 1024, WGU + (size_t)e * 1024 * 1024 + (size_t)drow * 1024 + k0, 1024, scr, F.lane); }
        else { const int q = it - I_GU, e = q >> 8, r = q & 255, kb = r >> 5, nb = r & 31, n0 = nb * 32, k0 = kb * 64;
            transpose_item(p.w_dn + (size_t)e * 512 * 1024 + (size_t)k0 * 1024 + n0, 1024, WDN + (size_t)e * 1024 * 512 + (size_t)n0 * 512 + k0, 512, scr, F.lane); }
    }
}

__device__ __forceinline__ void p0_prologue(const Params& p, Frame& F) {
    LAS float* scr = (LAS float*)(F.lds + F.wave * 16384);
    bf16* WIN = (bf16*)(p.ws + WS_WIN); bf16* WPE = (bf16*)(p.ws + WS_WPE); bf16* WSO = (bf16*)(p.ws + WS_WSO); bf16* WOUT = (bf16*)(p.ws + WS_WOUT); bf16* WR = (bf16*)(p.ws + WS_WR);
    bf16* XN = (bf16*)(p.ws + WS_XN);
    for (int it = F.vcu; it < 256; it += F.G) {
        const int rt = it >> 4, ct = it & 15, q = rt >> 2, r0 = (rt & 3) * 64, n0 = ct * 64;
        LAS float* As = (LAS float*)F.lds; LAS float* Bs = As + 64 * 33;
        const int ty = F.tid >> 4, tx = F.tid & 15;
        float acc[2][4] = {{0.f, 0.f, 0.f, 0.f}, {0.f, 0.f, 0.f, 0.f}};
        for (int m0 = 0; m0 < 256; m0 += 32) {
            __syncthreads();
#pragma unroll
            for (int i = 0; i < 4; ++i) { const int idx = F.tid + 512 * i, rr = idx >> 5, mm = idx & 31;
                As[rr * 33 + mm] = p.pool_w[((size_t)q * 256 + r0 + rr) * 256 + m0 + mm] * p.pool_scale[q * 256 + m0 + mm];
                const int bm = idx >> 6, bn = idx & 63;
                Bs[bm * 65 + bn] = p.w_pool_out[(size_t)(q * 256 + m0 + bm) * 1024 + n0 + bn]; }
            __syncthreads();
#pragma unroll 8
            for (int mm = 0; mm < 32; ++mm) { const float a0 = As[(2 * ty) * 33 + mm], a1 = As[(2 * ty + 1) * 33 + mm];
#pragma unroll
                for (int j = 0; j < 4; ++j) { const float bv = Bs[mm * 65 + 4 * tx + j]; acc[0][j] += a0 * bv; acc[1][j] += a1 * bv; } }
        }
#pragma unroll
        for (int i = 0; i < 2; ++i)
#pragma unroll
            for (int j = 0; j < 4; ++j) WPE[(size_t)(n0 + 4 * tx + j) * 1024 + q * 256 + r0 + 2 * ty + i] = (bf16)f2bf(acc[i][j]);
        __syncthreads();
    }
    const int gw = F.vcu * NWAVES + F.wave, NGW = F.G * NWAVES;
    constexpr int I_IN = 16 * 257, I_SO = 32 * 32, I_OUT = 16 * 32;
    for (int it = gw; it < I_IN + I_SO + I_OUT; it += NGW) {
        int r = it;
        if (r < I_IN) { const int kb = r / 257, nb = r % 257, n0 = nb * 32, k0 = kb * 64;
            const int drow = n0 < 6144 ? n0 : (n0 < 6176 ? 8192 + (n0 - 6144) : n0 - 32);
            transpose_item(p.w_in + (size_t)k0 * DIN + n0, DIN, WIN + (size_t)drow * 1024 + k0, 1024, scr, F.lane); continue; }
        r -= I_IN;
        if (r < I_SO) { const int kb = r >> 5, nb = r & 31; transpose_item(p.w_ssd_out + (size_t)kb * 64 * 1024 + nb * 32, 1024, WSO + (size_t)nb * 32 * 2048 + kb * 64, 2048, scr, F.lane); continue; }
        r -= I_SO;
        { const int kb = r >> 5, nb = r & 31; transpose_item(p.w_out + (size_t)kb * 64 * 1024 + nb * 32, 1024, WOUT + (size_t)nb * 32 * 1024 + kb * 64, 1024, scr, F.lane); }
    }
    for (size_t i = (size_t)(F.vcu * NTHR + F.tid); i < (size_t)(NPROJ - DIN) * 1024 / 8; i += (size_t)F.G * NTHR) ((GAS v4u*)(WIN + (size_t)DIN * 1024))[i] = (v4u){0u, 0u, 0u, 0u};
    for (int i = F.vcu * NTHR + F.tid; i < 256 * 1024; i += F.G * NTHR) { const int n = i >> 10, k = i & 1023;
        const float v = n < 8 ? p.w_rg[k * 8 + n] : (n < 72 ? p.w_re[k * 64 + n - 8] : 0.f); WR[i] = (bf16)f2bf(v); }
    for (int m = gw; m < MROWS; m += NGW) {
        if (m < TOK) rms_row_to_bf16(p.x + (size_t)m * 1024, p.norm_mix, XN + (size_t)m * 1024, F.lane);
        else if (m < TOK + NMETA) rms_row_to_bf16(p.meta + (size_t)(m - TOK) * 1024, p.norm_mix, XN + (size_t)m * 1024, F.lane);
        else { GAS v4u* o = (GAS v4u*)(XN + (size_t)m * 1024) + F.lane; o[0] = (v4u){0u, 0u, 0u, 0u}; o[64] = (v4u){0u, 0u, 0u, 0u}; }
    }
}

__device__ __forceinline__ void unpack8(const v4u w, float (&f)[8]) { f[0] = bflo(w.x); f[1] = bfhi(w.x); f[2] = bflo(w.y); f[3] = bfhi(w.y); f[4] = bflo(w.z); f[5] = bfhi(w.z); f[6] = bflo(w.w); f[7] = bfhi(w.w); }

__device__ __forceinline__ void prep_conv_item(const Params& p, Frame& F, int b, int c, int slab) {
    const bf16* XBC = (const bf16*)(p.ws + WS_XBC);
    bf16* XST = (bf16*)(p.ws + WS_XST); bf16* BT = (bf16*)(p.ws + WS_BT); bf16* CN = (bf16*)(p.ws + WS_CN); bf16* GM = (bf16*)(p.ws + WS_G);
    const int cg = F.tid & 31, rseg = F.tid >> 5, l0 = rseg * 8, P0 = c * CHUNK;
    const bool bc = slab >= 8; const int g = slab - 8;
    const int ch = !bc ? slab * 256 + cg * 8 : (cg < 16 ? 2048 + g * 128 + cg * 8 : 2560 + g * 128 + (cg - 16) * 8);
    v4u on[8];
    {
        float wk[4][8], bias[8];
#pragma unroll
        for (int k = 0; k < 4; ++k) { const f32x4 a = *(const GAS f32x4*)(p.conv_w + k * CONVD + ch), b2 = *(const GAS f32x4*)(p.conv_w + k * CONVD + ch + 4);
            wk[k][0] = a.x; wk[k][1] = a.y; wk[k][2] = a.z; wk[k][3] = a.w; wk[k][4] = b2.x; wk[k][5] = b2.y; wk[k][6] = b2.z; wk[k][7] = b2.w; }
        { const f32x4 a = *(const GAS f32x4*)(p.conv_b + ch), b2 = *(const GAS f32x4*)(p.conv_b + ch + 4);
            bias[0] = a.x; bias[1] = a.y; bias[2] = a.z; bias[3] = a.w; bias[4] = b2.x; bias[5] = b2.y; bias[6] = b2.z; bias[7] = b2.w; }
        v4u xr[11];
#pragma unroll
        for (int r = 0; r < 11; ++r) { const int s = P0 + l0 + r - 3 - 112;
            xr[r] = (s >= 0) ? *(const GAS v4u*)(XBC + (size_t)seq_row(b, s) * CONVD + ch) : (v4u){0u, 0u, 0u, 0u}; }
#pragma unroll
        for (int j = 0; j < 8; ++j) {
            float a[8];
#pragma unroll
            for (int i = 0; i < 8; ++i) a[i] = bias[i];
#pragma unroll
            for (int k = 0; k < 4; ++k) { float xf[8]; unpack8(xr[j + k], xf);
#pragma unroll
                for (int i = 0; i < 8; ++i) a[i] += wk[k][i] * xf[i]; }
            const bool valid = (P0 + l0 + j - 112) >= 0;
#pragma unroll
            for (int i = 0; i < 8; ++i) a[i] = valid ? pg8::silu_f(a[i]) : 0.f;
            on[j] = (v4u){pk2(a[0], a[1]), pk2(a[2], a[3]), pk2(a[4], a[5]), pk2(a[6], a[7])};
        }
    }
    LAS unsigned char* T = F.lds;
    LAS unsigned char* TT = bc ? F.lds + 69632 : F.lds;
    if (!bc || cg < 16) {
#pragma unroll
        for (int i = 0; i < 8; ++i) {
            const int q = i >> 1; v4u t;
            unsigned e[8];
#pragma unroll
            for (int j = 0; j < 8; ++j) { const unsigned w = q == 0 ? on[j].x : (q == 1 ? on[j].y : (q == 2 ? on[j].z : on[j].w)); e[j] = (i & 1) ? (w >> 16) : (w & 0xffffu); }
            t.x = e[0] | (e[1] << 16); t.y = e[2] | (e[3] << 16); t.z = e[4] | (e[5] << 16); t.w = e[6] | (e[7] << 16);
            const int chl = cg * 8 + i;
            *(LAS v4u*)(TT + chl * 256 + ((rseg ^ (cg & 15)) << 4)) = t;
        }
    }
    if (bc) {
#pragma unroll
        for (int j = 0; j < 8; ++j) *(LAS v4u*)(T + (l0 + j) * 528 + cg * 16) = on[j];
        if (cg >= 16) {
#pragma unroll
            for (int j = 0; j < 8; ++j) { const int P = P0 + l0 + j, nch = cg - 16;
                *(GAS v4u*)(CN + ((((size_t)(b * (PADLEN / 16) + (P >> 4)) * 4 + g) * 4 + (nch >> 2)) * 64 + (nch & 3) * 16 + (P & 15)) * 8) = on[j]; }
        }
    }
    __syncthreads();
    if (!bc) {
#pragma unroll
        for (int i = 0; i < 8; ++i) { const int v = F.tid + 512 * i, lg = v & 15, chl = v >> 4, h = slab * 4 + (chl >> 6), pp = chl & 63;
            const v4u t = *(const LAS v4u*)(TT + chl * 256 + ((lg ^ ((chl >> 3) & 15)) << 4));
            *(GAS v4u*)(XST + ((size_t)(b * HEADS + h) * HD + pp) * PADLEN + P0 + 8 * lg) = t; }
    } else {
#pragma unroll
        for (int i = 0; i < 4; ++i) { const int v = F.tid + 512 * i, lg = v & 15, n = v >> 4;
            const v4u t = *(const LAS v4u*)(TT + n * 256 + ((lg ^ ((n >> 3) & 15)) << 4));
            *(GAS v4u*)(BT + ((((size_t)(b * GROUPS + g) * 8 + (n >> 4)) * (PADLEN / 32) + c * 4 + (lg >> 2)) * 64 + (lg & 3) * 16 + (n & 15)) * 8) = t; }
        if (c >= 1) {
            const int w = F.wave, fr = F.lane & 15, fq = F.lane >> 4;
            bf16x8 Cf[4];
#pragma unroll
            for (int ks = 0; ks < 4; ++ks) Cf[ks] = *(const LAS bf16x8*)(T + (16 * w + fr) * 528 + (128 + 32 * ks + 8 * fq) * 2);
            bf16* Gp = GM + ((size_t)(((b * NCH + c) * GROUPS + g) * 8 + w) * 4) * 512 + fr * 8;
            for (int st = 0; st <= w; ++st) {
                f32x4 acc = (f32x4){0.f, 0.f, 0.f, 0.f};
#pragma unroll
                for (int ks = 0; ks < 4; ++ks) { const bf16x8 Bf = *(const LAS bf16x8*)(T + (16 * st + fr) * 528 + (32 * ks + 8 * fq) * 2);
                    acc = __builtin_amdgcn_mfma_f32_16x16x32_bf16(Bf, Cf[ks], acc, 0, 0, 0); }
                v2u o; o.x = pk2(acc[0], acc[1]); o.y = pk2(acc[2], acc[3]);
                *(GAS v2u*)(Gp + (st >> 1) * 512 + (2 * (st & 1) + (fq >> 1)) * 128 + 4 * (fq & 1)) = o;
            }
        }
    }
    __syncthreads();
}
__device__ __forceinline__ void prep_pool_item(const Params& p, Frame& F, int b, int c) {
    const bf16* U = (const bf16*)(p.ws + WS_U); bf16* D = (bf16*)(p.ws + WS_D);
    const int cgp = F.tid & 127, rs = F.tid >> 7, ch = cgp * 8, w = 2 << (cgp >> 5);
    const int t0 = (c - 1) * CHUNK + rs * 32, s0 = t0 + NMETA;
    float sum[8];
#pragma unroll
    for (int i = 0; i < 8; ++i) sum[i] = 0.f;
    for (int j = 1; j < w; ++j) { float f[8]; unpack8(*(const GAS v4u*)(U + (size_t)seq_row(b, s0 - j) * 1024 + ch), f);
#pragma unroll
        for (int i = 0; i < 8; ++i) sum[i] += f[i]; }
    const float inv = 1.0f / (float)w;
    for (int r = 0; r < 32; ++r) { const int s = s0 + r; float cur[8], old[8], d[8];
        unpack8(*(const GAS v4u*)(U + (size_t)seq_row(b, s) * 1024 + ch), cur);
        unpack8(*(const GAS v4u*)(U + (size_t)seq_row(b, s - w + 1) * 1024 + ch), old);
#pragma unroll
        for (int i = 0; i < 8; ++i) { sum[i] += cur[i]; d[i] = sum[i] * inv - cur[i]; sum[i] -= old[i]; }
        *(GAS v4u*)(D + (size_t)(b * SEQ + t0 + r) * 1024 + ch) = (v4u){pk2(d[0], d[1]), pk2(d[2], d[3]), pk2(d[4], d[5]), pk2(d[6], d[7])}; }
}
__device__ __forceinline__ void prep_dt_item(const Params& p, Frame& F, int b, int c) {
    const float* DT = (const float*)(p.ws + WS_DT); float* ACS = (float*)(p.ws + WS_ACS); float* DTC = (float*)(p.ws + WS_DTC);
    LAS float* al = (LAS float*)F.lds; LAS float* dl = al + 128 * 33;
    for (int idx = F.tid; idx < 4096; idx += NTHR) { const int l = idx >> 5, h = idx & 31, s = c * CHUNK + l - 112;
        const float dt = s >= 0 ? DT[(size_t)seq_row(b, s) * 32 + h] : 0.f;
        dl[l * 33 + h] = dt; al[l * 33 + h] = dt * (-__expf(p.a_log[h])) * 1.4426950408889634f; }
    __syncthreads();
    if (F.tid < 32) { float run = 0.f; for (int l = 0; l < 128; ++l) { run += al[l * 33 + F.tid]; al[l * 33 + F.tid] = run; } }
    __syncthreads();
    for (int idx = F.tid; idx < 4096; idx += NTHR) { const int h = idx >> 7, l = idx & 127; const size_t o = (size_t)(b * HEADS + h) * PADLEN + c * CHUNK + l;
        ACS[o] = al[l * 33 + h]; DTC[o] = dl[l * 33 + h]; }
    __syncthreads();
}
__device__ __forceinline__ void p2_prep(const Params& p, Frame& F) {
    constexpr int I_A = BATCH * NCH * 12, I_B = BATCH * 64, I_C = BATCH * NCH;
    for (int it = F.vcu; it < I_A + I_B + I_C; it += F.G) {
        if (it < I_A) { const int slab = it % 12, bc = it / 12; prep_conv_item(p, F, bc / NCH, bc % NCH, slab); }
        else if (it < I_A + I_B) { const int q = it - I_A; prep_pool_item(p, F, q >> 6, (q & 63) + 1); }
        else { const int q = it - I_A - I_B; prep_dt_item(p, F, q / NCH, q % NCH); }
    }
}

constexpr int WK_XS = 0, WK_AC = 8704, WK_WL = 9216, WK_BUF = 9728, WK_SBF = 2 * WK_BUF, WK_SBFSZ = 8704;
static_assert(WK_SBF + 2 * WK_SBFSZ <= RING_BYTES, "walk LDS");
#define WK_BARRIER() do { asm volatile("s_waitcnt lgkmcnt(0)" ::: "memory"); __builtin_amdgcn_s_barrier(); asm volatile("" ::: "memory"); } while (0)
struct WkR { v4u C[4], B[4], xv; float a, d, e; };
__device__ __forceinline__ void ssd_walk_item(const Params& p, Frame& F, int b, int h, int ph) {
    const int g = h >> 3, w = F.wave, fr = F.lane & 15, fq = F.lane >> 4, tid = F.tid;
    const int lrow = 16 * w + fr;
    const bf16* XST = (const bf16*)(p.ws + WS_XST); const bf16* BT = (const bf16*)(p.ws + WS_BT); const bf16* CN = (const bf16*)(p.ws + WS_CN);
    const float* ACS = (const float*)(p.ws + WS_ACS) + (size_t)(b * HEADS + h) * PADLEN; const float* DTC = (const float*)(p.ws + WS_DTC) + (size_t)(b * HEADS + h) * PADLEN;
    bf16* Y = (bf16*)(p.ws + WS_Y);
    const int xp = tid >> 4, xlg = tid & 15;
    const bf16* xsrc = XST + ((size_t)(b * HEADS + h) * HD + 32 * ph + xp) * PADLEN + 8 * xlg;
    const bf16* bsrc = BT + (((size_t)(b * GROUPS + g) * 8 + w) * (PADLEN / 32)) * 512 + F.lane * 8;
    const bf16* csrc = CN + (((size_t)(b * (PADLEN / 16) + w) * 4 + g) * 4) * 512 + F.lane * 8;
    WkR R0, R1, R2;
#define WK_LOAD(R_, c_) do { const int c__ = (c_); const int t7 = tid & 127; \
        asm volatile("global_load_dwordx4 %0, %1, off" : "=v"(R_.xv) : "v"(xsrc + c__ * CHUNK) : "memory"); \
        asm volatile("global_load_dword %0, %1, off" : "=v"(R_.a) : "v"(ACS + c__ * CHUNK + t7) : "memory"); \
        asm volatile("global_load_dword %0, %1, off" : "=v"(R_.d) : "v"(DTC + c__ * CHUNK + t7) : "memory"); \
        asm volatile("global_load_dword %0, %1, off" : "=v"(R_.e) : "v"(ACS + c__ * CHUNK + 127) : "memory"); \
        _Pragma("unroll") for (int ks = 0; ks < 4; ++ks) { \
            asm volatile("global_load_dwordx4 %0, %1, off" : "=v"(R_.C[ks]) : "v"(csrc + (size_t)c__ * 65536 + ks * 512) : "memory"); \
            asm volatile("global_load_dwordx4 %0, %1, off" : "=v"(R_.B[ks]) : "v"(bsrc + (c__ * 4 + ks) * 512) : "memory"); } } while (0)
#define WK_WAIT_X(N_, R_) asm volatile("s_waitcnt vmcnt(" #N_ ")" : "+v"(R_.xv), "+v"(R_.a), "+v"(R_.d), "+v"(R_.e) :: "memory")
#define WK_WAIT_CB(N_, R_) asm volatile("s_waitcnt vmcnt(" #N_ ")" : "+v"(R_.C[0]), "+v"(R_.C[1]), "+v"(R_.C[2]), "+v"(R_.C[3]), "+v"(R_.B[0]), "+v"(R_.B[1]), "+v"(R_.B[2]), "+v"(R_.B[3]) :: "memory")
#define WK_STAGE(R_, buf_) do { LAS unsigned char* B_ = F.lds + (buf_) * WK_BUF; \
        *(LAS v4u*)(B_ + WK_XS + xp * 272 + xlg * 16) = R_.xv; \
        if (tid < 128) { *(LAS float*)(B_ + WK_AC + tid * 4) = R_.a; *(LAS float*)(B_ + WK_WL + tid * 4) = R_.d * __builtin_amdgcn_exp2f(R_.e - R_.a); } } while (0)
#define WK_STEP(c_, Rc_, Rn1_, Rn2_) do { const int cc_ = (c_); if (cc_ < NCH) { const int buf_ = cc_ & 1; \
        if (cc_ + 2 < NCH) { WK_LOAD(Rn2_, cc_ + 2); } else { asm volatile("s_waitcnt vmcnt(0)" ::: "memory"); } WK_WAIT_CB(24, Rc_);     \
        const LAS unsigned char* B_ = F.lds + buf_ * WK_BUF; \
        const LAS unsigned char* SB = F.lds + WK_SBF + buf_ * WK_SBFSZ; LAS unsigned char* SBn = F.lds + WK_SBF + (1 - buf_) * WK_SBFSZ; \
        const LAS float* AC = (const LAS float*)(B_ + WK_AC); const LAS float* WL = (const LAS float*)(B_ + WK_WL); \
        if (cc_ >= 1) { \
            f32x4 acc2[2] = {(f32x4){0.f, 0.f, 0.f, 0.f}, (f32x4){0.f, 0.f, 0.f, 0.f}}; \
            _Pragma("unroll") for (int ks = 0; ks < 4; ++ks) { const bf16x8 Cf = __builtin_bit_cast(bf16x8, Rc_.C[ks]); \
                _Pragma("unroll") for (int pt = 0; pt < 2; ++pt) { const bf16x8 Sfr = *(const LAS bf16x8*)(SB + (16 * pt + fr) * 272 + (32 * ks + 8 * fq) * 2); \
                    acc2[pt] = __builtin_amdgcn_mfma_f32_16x16x32_bf16(Sfr, Cf, acc2[pt], 0, 0, 0); } } \
            const float ea = __builtin_amdgcn_exp2f(AC[lrow]); \
            bf16* yblk = Y + ((((size_t)(b * 64 + cc_ - 1) * HEADS + h) * 8 + w) * 4 + 2 * ph) * 256 + F.lane * 4;     \
            _Pragma("unroll") for (int pt = 0; pt < 2; ++pt) { const f32x4 yv = acc2[pt] * ea; v2u o; o.x = pk2(yv[0], yv[1]); o.y = pk2(yv[2], yv[3]); *(GAS v2u*)(yblk + pt * 256) = o; } \
        } \
        { const float alpha = __builtin_amdgcn_exp2f(AC[127]); \
            accS[0] = accS[0] * alpha; accS[1] = accS[1] * alpha; \
            _Pragma("unroll") for (int ks = 0; ks < 4; ++ks) { float bv[8]; unpack8(Rc_.B[ks], bv); \
                const f32x4 w0 = *(const LAS f32x4*)(WL + 32 * ks + 8 * fq), w1 = *(const LAS f32x4*)(WL + 32 * ks + 8 * fq + 4); \
                const v4u bp = (v4u){pk2(bv[0] * w0.x, bv[1] * w0.y), pk2(bv[2] * w0.z, bv[3] * w0.w), pk2(bv[4] * w1.x, bv[5] * w1.y), pk2(bv[6] * w1.z, bv[7] * w1.w)}; \
                const bf16x8 Bf = __builtin_bit_cast(bf16x8, bp); \
                _Pragma("unroll") for (int pt = 0; pt < 2; ++pt) { const bf16x8 Xf = *(const LAS bf16x8*)(B_ + WK_XS + (16 * pt + fr) * 272 + (32 * ks + 8 * fq) * 2); \
                    accS[pt] = __builtin_amdgcn_mfma_f32_16x16x32_bf16(Bf, Xf, accS[pt], 0, 0, 0); } } \
            _Pragma("unroll") for (int pt = 0; pt < 2; ++pt) { v2u o; o.x = pk2(accS[pt][0], accS[pt][1]); o.y = pk2(accS[pt][2], accS[pt][3]); \
                *(LAS v2u*)(SBn + (16 * pt + fr) * 272 + (16 * w + 4 * fq) * 2) = o; } } \
        if (cc_ + 1 < NCH) { WK_WAIT_X(20, Rn1_); WK_STAGE(Rn1_, 1 - buf_); }         \
        WK_BARRIER(); } } while (0)
    for (int i = tid; i < WK_SBFSZ / 16; i += NTHR) *(LAS v4u*)(F.lds + WK_SBF + i * 16) = (v4u){0u, 0u, 0u, 0u};
    WK_LOAD(R0, 0); WK_LOAD(R1, 1); WK_WAIT_X(20, R0); WK_STAGE(R0, 0);
    WK_BARRIER();
    f32x4 accS[2] = {(f32x4){0.f, 0.f, 0.f, 0.f}, (f32x4){0.f, 0.f, 0.f, 0.f}};
    for (int c3 = 0; c3 < NCH; c3 += 3) { WK_STEP(c3, R0, R1, R2); WK_STEP(c3 + 1, R1, R2, R0); WK_STEP(c3 + 2, R2, R0, R1); }
    asm volatile("s_waitcnt vmcnt(0)" ::: "memory");
    __syncthreads();
#undef WK_LOAD
#undef WK_STAGE
#undef WK_STEP
#undef WK_WAIT_X
#undef WK_WAIT_CB
}

constexpr int P4_YT = 0, P4_YTP = 1040, P4_XT = 128 * P4_YTP, P4_AC = P4_XT + 64 * 272;
static_assert(P4_AC + 1024 <= P4_BYTES, "phase 4 LDS");
__device__ __forceinline__ void p4_item(const Params& p, Frame& F, int b, int c, int g) {
    const int w = F.wave, fr = F.lane & 15, fq = F.lane >> 4, tid = F.tid;
    const int lt = w < 4 ? w : 11 - w, lrow = 16 * lt + fr, kmax = lt >> 1;
    const bf16* XST = (const bf16*)(p.ws + WS_XST); const bf16* GM = (const bf16*)(p.ws + WS_G);
    const float* ACS = (const float*)(p.ws + WS_ACS); const float* DTC = (const float*)(p.ws + WS_DTC);
    const bf16* YOFF = (const bf16*)(p.ws + WS_Y); const bf16* Z = (const bf16*)(p.ws + WS_Z); bf16* YN = (bf16*)(p.ws + WS_YN);
    const size_t mrow0 = (size_t)(b * SEQ + (c - 1) * CHUNK);
    v4u Gc[4];
#pragma unroll
    for (int ks = 0; ks < 4; ++ks) if (ks <= kmax) Gc[ks] = *(const GAS v4u*)(GM + ((size_t)((((b * NCH + c) * GROUPS + g) * 8 + lt) * 4 + ks)) * 512 + F.lane * 8);
    const int xp = tid >> 4, xlg = tid & 15;
    v4u xv[2]; float av = 0.f;
#define P4_LOAD(hh_) do { const int h__ = 8 * g + (hh_); \
        _Pragma("unroll") for (int i = 0; i < 2; ++i) xv[i] = *(const GAS v4u*)(XST + ((size_t)(b * HEADS + h__) * HD + xp + 32 * i) * PADLEN + c * CHUNK + 8 * xlg); \
        if (tid < 128) av = ACS[(size_t)(b * HEADS + h__) * PADLEN + c * CHUNK + tid]; else if (tid < 256) av = DTC[(size_t)(b * HEADS + h__) * PADLEN + c * CHUNK + tid - 128]; } while (0)
    P4_LOAD(0);
    LAS unsigned char* YT = F.lds + P4_YT; LAS unsigned char* XT = F.lds + P4_XT;
    const LAS float* AC = (const LAS float*)(F.lds + P4_AC); const LAS float* DL = AC + 128;
#pragma unroll 1
    for (int hh = 0; hh < 8; ++hh) {
        const int h = 8 * g + hh;
#pragma unroll
        for (int i = 0; i < 2; ++i) *(LAS v4u*)(XT + (xp + 32 * i) * 272 + xlg * 16) = xv[i];
        if (tid < 256) *(LAS float*)(F.lds + P4_AC + tid * 4) = av;
        WK_BARRIER();
        if (hh + 1 < 8) P4_LOAD(hh + 1);
        v2u yo[4];
        { const bf16* yb = YOFF + ((((size_t)(b * 64 + c - 1) * HEADS + h) * 8 + lt) * 4) * 256 + F.lane * 4;
#pragma unroll
          for (int pt = 0; pt < 4; ++pt) yo[pt] = *(const GAS v2u*)(yb + pt * 256); }
        const float acs_l = AC[lrow], Dh = p.d_skip[h];
        f32x4 acc[4] = {(f32x4){0.f, 0.f, 0.f, 0.f}, (f32x4){0.f, 0.f, 0.f, 0.f}, (f32x4){0.f, 0.f, 0.f, 0.f}, (f32x4){0.f, 0.f, 0.f, 0.f}};
#pragma unroll
        for (int ks = 0; ks < 4; ++ks) {
            if (ks <= kmax) {
                const int s0 = 32 * ks + 8 * fq; float gv[8]; unpack8(Gc[ks], gv);
                const f32x4 a0 = *(const LAS f32x4*)(AC + s0), a1 = *(const LAS f32x4*)(AC + s0 + 4), d0 = *(const LAS f32x4*)(DL + s0), d1 = *(const LAS f32x4*)(DL + s0 + 4);
                const float as[8] = {a0.x, a0.y, a0.z, a0.w, a1.x, a1.y, a1.z, a1.w}, ds[8] = {d0.x, d0.y, d0.z, d0.w, d1.x, d1.y, d1.z, d1.w};
                float sv[8];
                if (ks == kmax) {
#pragma unroll
                    for (int j = 0; j < 8; ++j) { const int s = s0 + j; float v = (s <= lrow) ? gv[j] * __builtin_amdgcn_exp2f(acs_l - as[j]) * ds[j] : 0.f; if (s == lrow) v += Dh; sv[j] = v; }
                } else {
#pragma unroll
                    for (int j = 0; j < 8; ++j) sv[j] = gv[j] * __builtin_amdgcn_exp2f(acs_l - as[j]) * ds[j];
                }
                const v4u sp = (v4u){pk2(sv[0], sv[1]), pk2(sv[2], sv[3]), pk2(sv[4], sv[5]), pk2(sv[6], sv[7])};
                const bf16x8 Sf = __builtin_bit_cast(bf16x8, sp);
#pragma unroll
                for (int pt = 0; pt < 4; ++pt) { const bf16x8 Xf = *(const LAS bf16x8*)(XT + (16 * pt + fr) * 272 + (32 * ks + 8 * fq) * 2);
                    acc[pt] = __builtin_amdgcn_mfma_f32_16x16x32_bf16(Xf, Sf, acc[pt], 0, 0, 0); }
            }
        }
#pragma unroll
        for (int pt = 0; pt < 4; ++pt) { v2u o; o.x = pk2(acc[pt][0] + bflo(yo[pt].x), acc[pt][1] + bfhi(yo[pt].x)); o.y = pk2(acc[pt][2] + bflo(yo[pt].y), acc[pt][3] + bfhi(yo[pt].y));
            *(LAS v2u*)(YT + lrow * P4_YTP + (hh * 64 + 16 * pt + 4 * fq) * 2) = o; }
        WK_BARRIER();
    }
#pragma unroll 2
    for (int i = 0; i < 16; ++i) { const int r = 16 * w + i; const size_t go = (mrow0 + r) * 2048 + g * 512 + 8 * F.lane;
        float yf[8], zf[8], v[8];
        unpack8(*(const GAS v4u*)(Z + go), zf); unpack8(*(const LAS v4u*)(YT + r * P4_YTP + F.lane * 16), yf);
        float ss = 0.f;
#pragma unroll
        for (int j = 0; j < 8; ++j) { v[j] = yf[j] * pg8::silu_f(zf[j]); ss += v[j] * v[j]; }
        const float rstd = 1.0f / sqrtf(wave_sum(ss) * (1.f / 512.f) + EPS);
        const f32x4 g0 = *(const GAS f32x4*)(p.ssd_norm + g * 512 + 8 * F.lane), g1 = *(const GAS f32x4*)(p.ssd_norm + g * 512 + 8 * F.lane + 4);
        *(GAS v4u*)(YN + go) = (v4u){pk2(v[0] * rstd * g0.x, v[1] * rstd * g0.y), pk2(v[2] * rstd * g0.z, v[3] * rstd * g0.w), pk2(v[4] * rstd * g1.x, v[5] * rstd * g1.y), pk2(v[6] * rstd * g1.z, v[7] * rstd * g1.w)}; }
    WK_BARRIER();
#undef P4_LOAD
}
__device__ __forceinline__ void p4_gate_norm(const Params& p, Frame& F) {
    for (int it = F.vcu; it < BATCH * 64 * GROUPS; it += F.G) { const int g = it & 3, bc = it >> 2; p4_item(p, F, bc >> 6, (bc & 63) + 1, g); }
}

__device__ __forceinline__ void build_moe_tables(Frame& F) {
    LAS unsigned* TBL = (LAS unsigned*)(F.lds + TBL_OFF); LAS unsigned* PST = (LAS unsigned*)(F.lds + PST_OFF);
    if (F.wave == 0) {
        const unsigned cn = __hip_atomic_load(F.ctl + CW_CNT + F.lane, RLX_AGENT); const unsigned nb = (cn + 255u) >> 8;
        unsigned x = nb;
#pragma unroll
        for (int o = 1; o < 64; o <<= 1) { const unsigned y = __shfl_up(x, o); if (F.lane >= o) x += y; }
        const unsigned bstart = x - nb;
        PST[F.lane] = bstart * 256u;
        if (F.lane == 63) PST[64] = x;
        for (unsigned k = 0; k < nb; ++k) { const unsigned rem = cn - 256u * k; TBL[bstart + k] = (unsigned)F.lane | ((rem < 256u ? rem : 256u) << 8); }
    }
    __syncthreads();
}

__device__ __forceinline__ void p9_gather(const Params& p, Frame& F) {
    const int* asg_e = (const int*)(p.ws + WS_ASGE); const int* asg_pos = (const int*)(p.ws + WS_ASGP); const float* asg_w = (const float*)(p.ws + WS_ASGW);
    int* row_a = (int*)(p.ws + WS_ROWA); float* row_w = (float*)(p.ws + WS_ROWW); int* row_t = (int*)(p.ws + WS_ROWT); float* row_r = (float*)(p.ws + WS_ROWR);
    const float* SSQ = (const float*)(p.ws + WS_SSQ);
    const LAS unsigned* PST = (const LAS unsigned*)(F.lds + PST_OFF); const LAS unsigned* TBL = (const LAS unsigned*)(F.lds + TBL_OFF);
    const int gt = F.vcu * NTHR + F.tid, NGT = F.G * NTHR;
    for (int a = gt; a < 2 * TOK; a += NGT) {
        const int e = asg_e[a], pos = asg_pos[a]; const int dest = (int)PST[e] + pos, tok = a >> 1;
        const GAS f32x4* q = (const GAS f32x4*)(SSQ + (size_t)tok * 16); const f32x4 s4 = (q[0] + q[1]) + (q[2] + q[3]);
        row_t[dest] = tok; row_a[dest] = a; row_w[dest] = asg_w[a]; row_r[dest] = 1.0f / sqrtf(((s4[0] + s4[1]) + (s4[2] + s4[3])) * (1.f / 1024.f) + EPS);
    }
    const int nrows = (int)PST[64] * 256;
    for (int d = gt; d < nrows; d += NGT) { if ((d & 255) >= (int)(TBL[d >> 8] >> 8)) { row_t[d] = 0; row_r[d] = 0.f; } }
}
__device__ __forceinline__ void p12_final(const Params& p, Frame& F) {
    const float* H2 = (const float*)(p.ws + WS_H2); const bf16* SLOT = (const bf16*)(p.ws + WS_SLOT);
    const int gw = F.vcu * NWAVES + F.wave, NGW = F.G * NWAVES;
    for (int m = gw; m < TOK; m += NGW) {
        const GAS f32x4* hr = (const GAS f32x4*)(H2 + (size_t)m * 1024) + F.lane;
        const GAS v2u* s0 = (const GAS v2u*)(SLOT + (size_t)(2 * m) * 1024) + F.lane; const GAS v2u* s1 = (const GAS v2u*)(SLOT + (size_t)(2 * m + 1) * 1024) + F.lane;
        f32x4 v[4]; float ss = 0.f;
#pragma unroll
        for (int j = 0; j < 4; ++j) { v[j] = hr[64 * j]; const v2u a = s0[64 * j], c = s1[64 * j];
            v[j].x += bflo(a.x) + bflo(c.x); v[j].y += bfhi(a.x) + bfhi(c.x); v[j].z += bflo(a.y) + bflo(c.y); v[j].w += bfhi(a.y) + bfhi(c.y);
            ss += (v[j].x * v[j].x + v[j].y * v[j].y) + (v[j].z * v[j].z + v[j].w * v[j].w); }
        const float rstd = 1.0f / sqrtf(wave_sum(ss) * (1.f / 1024.f) + EPS);
        GAS f32x4* o = (GAS f32x4*)(p.out + (size_t)m * 1024) + F.lane; const GAS f32x4* gr = (const GAS f32x4*)p.norm_final + F.lane;
#pragma unroll
        for (int j = 0; j < 4; ++j) { const f32x4 g = gr[64 * j]; o[64 * j] = (f32x4){v[j].x * rstd * g.x, v[j].y * rstd * g.y, v[j].z * rstd * g.z, v[j].w * rstd * g.w}; }
    }
}

#ifndef DBG_REPMASK
#define DBG_REPMASK 0
#endif
#define NREP(k) (((DBG_REPMASK >> ((k) == 41 ? 13 : ((k) == 31 ? 14 : (k)))) & 1) ? 2 : 1)
__global__ void __launch_bounds__(NTHR, 2) mk_fwd(Params p) {
    extern __shared__ __attribute__((aligned(16))) unsigned char lds[];
    Frame F;
    F.lds = (LAS unsigned char*)lds; F.MISC = (volatile LAS unsigned*)(F.lds + MISC_OFF);
    F.tid = threadIdx.x; F.lane = F.tid & 63; F.wave = __builtin_amdgcn_readfirstlane(F.tid >> 6);
    F.G = gridDim.x; { const int bx = blockIdx.x; F.vcu = (F.G % 8 == 0) ? (bx % 8) * (F.G / 8) + bx / 8 : bx; }
    F.ctl = (gu32*)(p.ws + WS_CTL);
    for (int u = F.tid; u < (LDS_BYTES - LDSCTL_OFF) / 4; u += NTHR) ((LAS unsigned*)(F.lds + LDSCTL_OFF))[u] = 0u;
    __syncthreads();
    const int lo = p.ph_lo, hi = p.ph_hi;
    XcdBarrier bar; bar.bar = (unsigned*)(F.ctl + CW_BAR); bar.x = 0; bar.st = nullptr;
    if (hi - lo > 1) bar = xcd_barrier_post((unsigned*)(F.ctl + CW_BAR), F.MISC + 8);
#define IN(k) (lo <= (k) && (k) < hi)
#define SEAM(k) do { if (IN(k) && IN((k) + 1)) xcd_barrier(bar); } while (0)
    LAS unsigned char* ring = F.lds;
    unsigned char* ws = p.ws;
    bf16* XN = (bf16*)(ws + WS_XN); bf16* U = (bf16*)(ws + WS_U); bf16* Z = (bf16*)(ws + WS_Z); bf16* XBC = (bf16*)(ws + WS_XBC); bf16* GATE = (bf16*)(ws + WS_GATE);

    if (IN(0)) { for (int rep = 0; rep < NREP(0); ++rep) p0_prologue(p, F); }
    SEAM(0);
    if (IN(1)) {
        pg8::Gemm g{XN, (const bf16*)(ws + WS_WIN), MROWS, NPROJ, 1024, nullptr}; pg8::StaticOrder S; S.init(MROWS, NPROJ, F.G, (int)blockIdx.x);
        pg8::EpiProj E{U, Z, XBC, GATE, (float*)(ws + WS_DT), p.dt_bias};
        for (int rep = 0; rep < NREP(1); ++rep) pg8::gemm_phase<pg8::EpiProj, pg8::StaticOrder, true, true>(ring, g, S, E);
    }
    SEAM(1);
    if (IN(2)) { for (int rep = 0; rep < NREP(2); ++rep) p2_prep(p, F); }
    SEAM(2);
    if (IN(3)) {
        for (int rep = 0; rep < NREP(3); ++rep) for (int it = F.vcu; it < BATCH * HEADS * 2; it += F.G) { const int bg = it >> 4, inner = it & 15; ssd_walk_item(p, F, bg >> 2, (bg & 3) * 8 + (inner >> 1), inner & 1); }
        pg8::Gemm g{(const bf16*)(ws + WS_D), (const bf16*)(ws + WS_WPE), TOK, 1024, 1024, nullptr}; pg8::StaticOrder S; S.init(TOK, 1024, F.G, (int)blockIdx.x);
        pg8::EpiGateMul E{GATE, 2048, nullptr, (bf16*)(ws + WS_TMP)};
        for (int rep = 0; rep < NREP(31); ++rep) pg8::gemm_phase<pg8::EpiGateMul, pg8::StaticOrder, true, true>(ring, g, S, E);
    }
    SEAM(3);
    if (IN(4)) {
        for (int rep = 0; rep < NREP(4); ++rep) p4_gate_norm(p, F);
    }
    SEAM(4);
    if (IN(5)) {
        for (int rep = 0; rep < NREP(41); ++rep) moe_weight_items(p, F, (LAS float*)(F.lds + F.wave * 16384), F.vcu * NWAVES + F.wave, F.G * NWAVES);
        __syncthreads();
        pg8::Gemm g{(const bf16*)(ws + WS_YN), (const bf16*)(ws + WS_WSO), TOK, 1024, 2048, nullptr}; pg8::StaticOrder S; S.init(TOK, 1024, F.G, (int)blockIdx.x);
        pg8::EpiGateMul E{GATE + 1024, 2048, (const bf16*)(ws + WS_TMP), (bf16*)(ws + WS_MERGED)};
        for (int rep = 0; rep < NREP(5); ++rep) pg8::gemm_phase<pg8::EpiGateMul, pg8::StaticOrder, true, true>(ring, g, S, E);
    }
    SEAM(5);
    if (IN(6)) {
        pg8::Gemm g{(const bf16*)(ws + WS_MERGED), (const bf16*)(ws + WS_WOUT), TOK, 1024, 1024, nullptr}; pg8::StaticOrder S; S.init(TOK, 1024, F.G, (int)blockIdx.x);
        pg8::EpiResid E{p.x, (float*)(ws + WS_H2), (bf16*)(ws + WS_H2N), p.norm_ffn, (float*)(ws + WS_SSQ)};
        for (int rep = 0; rep < NREP(6); ++rep) pg8::gemm_phase<pg8::EpiResid, pg8::StaticOrder, true, true>(ring, g, S, E);
    }
    SEAM(6);
    if (IN(8)) {
        pg8::Gemm g{(const bf16*)(ws + WS_H2N), (const bf16*)(ws + WS_WR), TOK, 256, 1024, nullptr}; pg8::StaticOrder S; S.init(TOK, 256, F.G, (int)blockIdx.x);
        pg8::EpiRouter E{p.b_rg, p.b_re, (int*)(ws + WS_ASGE), (int*)(ws + WS_ASGP), (float*)(ws + WS_ASGW), (unsigned*)(F.ctl + CW_CNT), (const float*)(ws + WS_SSQ)};
        pg8::gemm_phase<pg8::EpiRouter, pg8::StaticOrder, false, true>(ring, g, S, E);
    }
    SEAM(8);
    if (IN(9)) { build_moe_tables(F); for (int rep = 0; rep < NREP(9); ++rep) p9_gather(p, F); }
    SEAM(9);
    if (IN(10)) {
        build_moe_tables(F);
        const LAS unsigned* TBL = (const LAS unsigned*)(F.lds + TBL_OFF); const int nblk = (int)((const LAS unsigned*)(F.lds + PST_OFF))[64];
        pg8::Gemm g{(const bf16*)(ws + WS_H2N), (const bf16*)(ws + WS_WGU), MAXBLK * 256, 1024, 1024, (const int*)(ws + WS_ROWT)}; pg8::MoeOrder S{TBL, nblk * 4, F.G, (int)blockIdx.x};
        pg8::EpiSwiGLU E{(bf16*)(ws + WS_ACT), (const float*)(ws + WS_ROWR)};
        for (int rep = 0; rep < NREP(10); ++rep) pg8::gemm_phase<pg8::EpiSwiGLU, pg8::MoeOrder, true, true, true>(ring, g, S, E);
    }
    SEAM(10);
    if (IN(11)) {
        build_moe_tables(F);
        const LAS unsigned* TBL = (const LAS unsigned*)(F.lds + TBL_OFF); const int nblk = (int)((const LAS unsigned*)(F.lds + PST_OFF))[64];
        pg8::Gemm g{(const bf16*)(ws + WS_ACT), (const bf16*)(ws + WS_WDN), MAXBLK * 256, 1024, 512, nullptr}; pg8::MoeOrder S{TBL, nblk * 4, F.G, (int)blockIdx.x};
        pg8::EpiMoeDown E{(const int*)(ws + WS_ROWA), (const float*)(ws + WS_ROWW), (bf16*)(ws + WS_SLOT), TBL};
        for (int rep = 0; rep < NREP(11); ++rep) pg8::gemm_phase<pg8::EpiMoeDown, pg8::MoeOrder, true, true>(ring, g, S, E);
    }
    SEAM(11);
    if (IN(12)) { for (int rep = 0; rep < NREP(12); ++rep) p12_final(p, F); }

#undef IN
#undef SEAM
}

extern "C" void kernel_launch(void* const* d_in, const int* in_sizes, int n_in, void* d_out, int out_size, void* d_ws, size_t ws_size, hipStream_t stream) {
    static int grid = 0;
    if (grid == 0) {
        if (n_in != 23 || in_sizes[0] != TOK * DM || out_size != TOK * DM || ws_size < WS_END) { fprintf(stderr, "kernel_launch: unexpected shapes: n_in %d in0 %d out %d ws %zu (need %zu)\n", n_in, n_in > 0 ? in_sizes[0] : -1, out_size, ws_size, (size_t)WS_END); grid = -1; return; }
        int dev = 0, cus = 0, per_cu = 0;
        if (hipGetDevice(&dev) != hipSuccess || hipDeviceGetAttribute(&cus, hipDeviceAttributeMultiprocessorCount, dev) != hipSuccess) { grid = -1; return; }
        if (hipFuncSetAttribute((const void*)mk_fwd, hipFuncAttributeMaxDynamicSharedMemorySize, LDS_BYTES) != hipSuccess) { fprintf(stderr, "kernel_launch: hipFuncSetAttribute failed\n"); grid = -1; return; }
        if (hipOccupancyMaxActiveBlocksPerMultiprocessor(&per_cu, (const void*)mk_fwd, NTHR, LDS_BYTES) != hipSuccess || per_cu < 1) { fprintf(stderr, "kernel_launch: occupancy query says %d\n", per_cu); }
        (void)hipGetLastError();
        grid = cus;
    }
    if (grid < 0) return;
    (void)hipMemsetAsync((char*)d_ws + WS_CTL, 0, CTL_ZERO_BYTES, stream);
    Params p{};
    const float** pf = (const float**)&p;
    for (int i = 0; i < 23; ++i) pf[i] = (const float*)d_in[i];
    p.out = (float*)d_out; p.ws = (unsigned char*)d_ws;
#if MK_ONE_LAUNCH
    p.ph_lo = 0; p.ph_hi = NPHASE;
    hipLaunchKernelGGL(mk_fwd, dim3(grid), dim3(NTHR), LDS_BYTES, stream, p);
#else
    for (int k = 0; k < NPHASE; ++k) { p.ph_lo = k; p.ph_hi = k + 1; hipLaunchKernelGGL(mk_fwd, dim3(grid), dim3(NTHR), LDS_BYTES, stream, p); }
#endif
}
```
